# Optimizing an MI355X kernel written in HIP

```python
import jax, jax.numpy as jnp
from jax import lax
import numpy as np

D_MODEL = 1024
BATCH = 1
SEQ = 16384
DEPTH = 4

HEAD_DIM = 64
N_MIXERS = 3
NORM_EPS = 1e-6
GRID_W = 64
A_HEADS = 16
A_KV = 4
A_G = A_HEADS // A_KV
A_WINDOW = 128
A_BLOCK = 128
B_HEADS = 16
B_KV = 4
B_G = B_HEADS // B_KV
B_BLOCK = 128
ROPE_THETA = 10000.0
C_GROUPS = ((128, 1), (512, 4), (2048, 16))
C_NGROUPS = len(C_GROUPS)
C_HEADS_PER_GROUP = 8
C_KV = 2
C_G = C_HEADS_PER_GROUP // C_KV
C_HEADS = C_NGROUPS * C_HEADS_PER_GROUP
C_BLOCK = max(w // d // 2 for w, d in C_GROUPS)

A_QW = A_HEADS * HEAD_DIM
A_KVW = A_KV * HEAD_DIM
A_OUT = A_QW
B_QW = B_HEADS * HEAD_DIM
B_KVW = B_KV * HEAD_DIM
B_OUT = B_QW
C_QW = C_HEADS * HEAD_DIM
C_KVW = C_NGROUPS * C_KV * HEAD_DIM
C_OUT = C_HEADS_PER_GROUP * HEAD_DIM
IN_WIDTH = (A_QW + 2 * A_KVW + A_OUT, B_QW + 2 * B_KVW + B_OUT, C_QW + 2 * C_KVW + C_OUT)
OUT_WIDTH = (A_OUT, B_OUT, C_OUT)

kernel_name = "hybrid_interleaved_bidir_attn_encoder"


def rms_norm(x, gain):
    xf = x.astype(jnp.float32)
    y = xf * lax.rsqrt(jnp.mean(xf * xf, axis=-1, keepdims=True) + NORM_EPS)
    return (y * gain.astype(jnp.float32)).astype(x.dtype)


def alibi_slopes(n):
    return jnp.asarray(2.0 ** (-8.0 * np.arange(1, n + 1) / n), dtype=jnp.float32)


def banded_attention(q, k, v, half, block, slopes, dist_scale, sink, length):
    n, L, kvh, g, dh = q.shape
    nb = L // block
    qb = q.reshape(n, nb, block, kvh, g, dh).astype(jnp.float32)

    def windows(t):
        tp = jnp.pad(t, ((0, 0), (block, block), (0, 0), (0, 0))).reshape(n, nb + 2, block, kvh, dh)
        return jnp.concatenate([tp[:, :-2], tp[:, 1:-1], tp[:, 2:]], axis=2).astype(jnp.float32)

    kw, vw = windows(k), windows(v)
    s = jnp.einsum("nbqkgd,nbckd->nbkgqc", qb, kw) * (dh ** -0.5)
    a = jnp.arange(block)[:, None]
    c = jnp.arange(3 * block)[None, :]
    rel = c - block - a
    kpos = jnp.arange(nb)[:, None, None] * block - block + c
    valid = (jnp.abs(rel) <= half) & (((kpos >= 0) & (kpos < length)) | (rel == 0))
    bias = -(slopes * dist_scale)[:, :, None, None] * jnp.abs(rel).astype(jnp.float32)
    s = jnp.where(valid[None, :, None, None], s + bias, -jnp.inf)
    m = jnp.max(s, axis=-1, keepdims=True)
    if sink is not None:
        sk = sink.astype(jnp.float32)[:, :, None, None]
        m = jnp.maximum(m, sk)
    p = jnp.exp(s - m)
    den = jnp.sum(p, axis=-1, keepdims=True)
    if sink is not None:
        den = den + jnp.exp(sk - m)
    o = jnp.einsum("nbkgqc,nbckd->nbqkgd", p / den, vw).reshape(n, L, kvh, g, dh)
    lse = jnp.moveaxis((m + jnp.log(den))[..., 0], 4, 2).reshape(n, L, kvh, g)
    return o.astype(q.dtype), lse


def mixer_a(h, w_in, q_gain, k_gain, sink, w_out):
    B, S, _ = h.shape
    q, k, v, gate = jnp.split(h @ w_in, [A_QW, A_QW + A_KVW, A_QW + 2 * A_KVW], axis=-1)
    q = rms_norm(q.reshape(B, S, A_KV, A_G, HEAD_DIM), q_gain)
    k = rms_norm(k.reshape(B, S, A_KV, HEAD_DIM), k_gain)
    v = v.reshape(B, S, A_KV, HEAD_DIM)
    slopes = alibi_slopes(A_HEADS).reshape(A_KV, A_G)
    o, _ = banded_attention(q, k, v, A_WINDOW, A_BLOCK, slopes, 1.0, sink.reshape(A_KV, A_G), S)
    return (o.reshape(B, S, A_OUT) * jax.nn.silu(gate)) @ w_out


def axial_rope_tables(S):
    rows = S // GRID_W
    row = jnp.repeat(jnp.arange(rows), GRID_W).astype(jnp.float32)
    col = jnp.tile(jnp.arange(GRID_W), rows).astype(jnp.float32)
    axis_dim = HEAD_DIM // 2
    freqs = 1.0 / (ROPE_THETA ** (jnp.arange(0, axis_dim, 2, dtype=jnp.float32) / axis_dim))
    ang = jnp.concatenate([row[:, None] * freqs, col[:, None] * freqs], axis=-1)
    return jnp.cos(ang), jnp.sin(ang)


def apply_rope(x, cos, sin):
    xf = x.astype(jnp.float32).reshape(*x.shape[:-1], HEAD_DIM // 2, 2)
    x1, x2 = xf[..., 0], xf[..., 1]
    out = jnp.stack([x1 * cos - x2 * sin, x1 * sin + x2 * cos], axis=-1)
    return out.reshape(x.shape).astype(x.dtype)


def dense_block_attention(q, k, v):
    B, S, kvh, g, dh = q.shape
    nb = S // B_BLOCK
    qb = jnp.moveaxis(q.reshape(B, nb, B_BLOCK, kvh, g, dh), 1, 0)
    kf, vf = k.astype(jnp.float32), v.astype(jnp.float32)

    def one_block(qblk):
        s = jnp.einsum("bqkgd,bskd->bkgqs", qblk.astype(jnp.float32), kf) * (dh ** -0.5)
        return jnp.einsum("bkgqs,bskd->bqkgd", jax.nn.softmax(s, axis=-1), vf)

    o = lax.map(one_block, qb)
    return jnp.moveaxis(o, 0, 1).reshape(B, S, kvh, g, dh).astype(q.dtype)


def mixer_b(h, w_in, q_gain, k_gain, w_out):
    B, S, _ = h.shape
    q, k, v, gate = jnp.split(h @ w_in, [B_QW, B_QW + B_KVW, B_QW + 2 * B_KVW], axis=-1)
    q = rms_norm(q.reshape(B, S, B_KV, B_G, HEAD_DIM), q_gain)
    k = rms_norm(k.reshape(B, S, B_KV, HEAD_DIM), k_gain)
    v = v.reshape(B, S, B_KV, HEAD_DIM)
    cos, sin = axial_rope_tables(S)
    q = apply_rope(q, cos[None, :, None, None, :], sin[None, :, None, None, :])
    k = apply_rope(k, cos[None, :, None, :], sin[None, :, None, :])
    o = dense_block_attention(q, k, v)
    return (o.reshape(B, S, B_OUT) * jax.nn.silu(gate)) @ w_out


def to_strided(t, dil, L, Lp):
    B = t.shape[0]
    rest = t.shape[2:]
    t = jnp.moveaxis(t.reshape(B, L, dil, *rest), 2, 1).reshape(B * dil, L, *rest)
    return jnp.pad(t, ((0, 0), (0, Lp - L)) + ((0, 0),) * len(rest))


def from_strided(t, B, dil, L):
    rest = t.shape[2:]
    t = t[:, :L].reshape(B, dil, L, *rest)
    return jnp.moveaxis(t, 1, 2).reshape(B, L * dil, *rest)


def mixer_c(h, w_in, q_gain, k_gain, w_out):
    B, S, _ = h.shape
    q, k, v, gate = jnp.split(h @ w_in, [C_QW, C_QW + C_KVW, C_QW + 2 * C_KVW], axis=-1)
    q = rms_norm(q.reshape(B, S, C_NGROUPS, C_KV, C_G, HEAD_DIM), q_gain)
    k = rms_norm(k.reshape(B, S, C_NGROUPS, C_KV, HEAD_DIM), k_gain)
    v = v.reshape(B, S, C_NGROUPS, C_KV, HEAD_DIM)
    slopes = alibi_slopes(C_HEADS).reshape(C_NGROUPS, C_KV, C_G)
    outs, lses = [], []
    for gi, (window, dil) in enumerate(C_GROUPS):
        half = window // dil // 2
        L = S // dil
        Lp = -(-L // C_BLOCK) * C_BLOCK
        qg = to_strided(q[:, :, gi], dil, L, Lp)
        kg = to_strided(k[:, :, gi], dil, L, Lp)
        vg = to_strided(v[:, :, gi], dil, L, Lp)
        o, lse = banded_attention(qg, kg, vg, half, C_BLOCK, slopes[gi], float(dil), None, L)
        outs.append(from_strided(o, B, dil, L))
        lses.append(from_strided(lse, B, dil, L))
    w = jax.nn.softmax(jnp.stack(lses, axis=0), axis=0)
    o = jnp.sum(w[..., None] * jnp.stack(outs, axis=0).astype(jnp.float32), axis=0).astype(h.dtype)
    return (o.reshape(B, S, C_OUT) * jax.nn.silu(gate)) @ w_out


def setup_inputs(seed: int = 0) -> dict:
    key = jax.random.key(seed)
    keys = jax.random.split(key, 1 + 6 * DEPTH)
    out = {"x": jax.random.normal(keys[0], (BATCH, SEQ, D_MODEL), jnp.float32)}
    for i in range(DEPTH):
        kind = i % N_MIXERS
        k = keys[1 + 6 * i: 7 + 6 * i]
        in_w, out_w = IN_WIDTH[kind], OUT_WIDTH[kind]
        out[f"l{i}_norm"] = 1.0 + 0.02 * jax.random.normal(k[0], (D_MODEL,), jnp.float32)
        out[f"l{i}_w_in"] = jax.random.normal(k[1], (D_MODEL, in_w), jnp.float32) * D_MODEL ** -0.5
        out[f"l{i}_q_gain"] = 1.0 + 0.02 * jax.random.normal(k[2], (HEAD_DIM,), jnp.float32)
        out[f"l{i}_k_gain"] = 1.0 + 0.02 * jax.random.normal(k[3], (HEAD_DIM,), jnp.float32)
        if kind == 0:
            out[f"l{i}_sink"] = 0.5 * jax.random.normal(k[4], (A_HEADS,), jnp.float32)
        out[f"l{i}_w_out"] = jax.random.normal(k[5], (out_w, D_MODEL), jnp.float32) * out_w ** -0.5
    return out


def reference(x, l0_norm, l0_w_in, l0_q_gain, l0_k_gain, l0_sink, l0_w_out,
              l1_norm, l1_w_in, l1_q_gain, l1_k_gain, l1_w_out,
              l2_norm, l2_w_in, l2_q_gain, l2_k_gain, l2_w_out,
              l3_norm, l3_w_in, l3_q_gain, l3_k_gain, l3_sink, l3_w_out):
    mixers = (mixer_a, mixer_b, mixer_c)
    layers = (
        (l0_norm, (l0_w_in, l0_q_gain, l0_k_gain, l0_sink, l0_w_out)),
        (l1_norm, (l1_w_in, l1_q_gain, l1_k_gain, l1_w_out)),
        (l2_norm, (l2_w_in, l2_q_gain, l2_k_gain, l2_w_out)),
        (l3_norm, (l3_w_in, l3_q_gain, l3_k_gain, l3_sink, l3_w_out)),
    )
    for i in range(DEPTH):
        norm, params = layers[i]
        x = x + mixers[i % N_MIXERS](rms_norm(x, norm), *params)
    return x
```

```cpp
#include <hip/hip_runtime.h>
#include <hip/hip_cooperative_groups.h>
#include <cstdio>
#ifndef PROBE_P3
#define PROBE_P3 0
#endif
#ifndef PROBE_P1
#define PROBE_P1 0
#endif
#ifndef PROBE_B
#define PROBE_B 0
#endif
#ifndef PROBE_AC
#define PROBE_AC 0
#endif
namespace cg = cooperative_groups;

typedef unsigned short bf16_t;
typedef short bf16x8 __attribute__((ext_vector_type(8)));
typedef float f32x16 __attribute__((ext_vector_type(16)));
typedef float f32x4 __attribute__((ext_vector_type(4)));
typedef float f32x2 __attribute__((ext_vector_type(2)));
typedef unsigned u32x4 __attribute__((ext_vector_type(4)));
typedef unsigned u32x2 __attribute__((ext_vector_type(2)));
typedef __bf16 bf2_t __attribute__((ext_vector_type(2)));
#define DI __device__ __forceinline__
#define MFMA32(a, b, c) __builtin_amdgcn_mfma_f32_32x32x16_bf16((a), (b), (c), 0, 0, 0)

constexpr int S = 16384, DM = 1024;
constexpr float EPS = 1e-6f;
constexpr float LOG2E = 1.4426950408889634f;

struct Params {
  const float* x;
  const float* norm[4]; const float* w_in[4]; const float* qg[4]; const float* kg[4]; const float* sink[4]; const float* w_out[4];
  float* out;
  bf16_t* wt_in[4]; bf16_t* wt_out[4];
  bf16_t* xb; float* rs;
  bf16_t* Q; bf16_t* K; bf16_t* Vt; bf16_t* SG; bf16_t* OG;
  f32x2* rope;
  unsigned char* wt8; unsigned char* xb8; unsigned char* wo8; unsigned char* og8;
  unsigned* bar; int use_cg; int pad0;
};

DI unsigned pk_bf16(float a, float b) { f32x2 v = {a, b}; bf2_t r = __builtin_convertvector(v, bf2_t); return __builtin_bit_cast(unsigned, r); }
DI int cvt4_fp8(float a, float b, float c, float d) { int w = __builtin_amdgcn_cvt_pk_fp8_f32(a, b, 0, false); return __builtin_amdgcn_cvt_pk_fp8_f32(c, d, w, true); }
DI int cvt4_bf8(float a, float b, float c, float d) { int w; asm volatile("" : "=v"(w)); w = __builtin_amdgcn_cvt_pk_bf8_f32(a, b, w, false); return __builtin_amdgcn_cvt_pk_bf8_f32(c, d, w, true); }
typedef __attribute__((address_space(3))) unsigned lds_u32;
typedef __attribute__((address_space(1))) const unsigned glb_u32;
DI void glds16(const void* g, char* l) { __builtin_amdgcn_global_load_lds((glb_u32*)g, (lds_u32*)l, 16, 0, 0); }
DI float bf_lo(unsigned w) { return __uint_as_float(w << 16); }
DI float bf_hi(unsigned w) { return __uint_as_float(w & 0xffff0000u); }
DI int nin_of(int kind) { return kind == 2 ? 2816 : 2560; }
DI int outw_of(int kind) { return kind == 2 ? 512 : 1024; }
DI int qw_of(int kind) { return kind == 2 ? 1536 : 1024; }
DI int kvw_of(int kind) { return kind == 2 ? 384 : 256; }
DI int lds_off(int row, int c) { return row * 128 + ((c ^ ((row >> 1) & 7)) << 4); }

struct TJob { const float* src; const float* gain; bf16_t* dst; unsigned char* dst8; int N, K, k0, n0; };
DI TJob tj_decode(const Params& p, int job, const int (&cum)[9]) {
  TJob j{};
#pragma unroll
  for (int l = 0; l < 4; ++l) {
    const int kind = l % 3;
    if (job >= cum[2 * l] && job < cum[2 * l + 1]) {
      const int q = job - cum[2 * l];
      j.src = p.w_in[l]; j.gain = p.norm[l]; j.dst = p.wt_in[l]; j.dst8 = l == 1 ? p.wt8 : nullptr; j.N = nin_of(kind); j.K = 1024; j.k0 = (q & 15) * 64; j.n0 = (q >> 4) * 64;
    } else if (job >= cum[2 * l + 1] && job < cum[2 * l + 2]) {
      const int q = job - cum[2 * l + 1], K = outw_of(kind), nkt = K / 64;
      j.src = p.w_out[l]; j.gain = nullptr; j.dst = p.wt_out[l]; j.dst8 = l == 1 ? p.wo8 : nullptr; j.N = 1024; j.K = K; j.k0 = (q % nkt) * 64; j.n0 = (q / nkt) * 64;
    }
  }
  return j;
}
DI void tj_load(const TJob& j, float (&v)[16], int tid) {
#pragma unroll
  for (int r = 0; r < 16; ++r) {
    const int kk = r * 4 + (tid >> 6), nn = tid & 63;
    v[r] = j.src[(size_t)(j.k0 + kk) * j.N + j.n0 + nn];
    if (j.gain) v[r] *= j.gain[j.k0 + kk];
  }
}
DI void tj_store(const TJob& j, const float (&v)[16], float* tile, int tid) {
#pragma unroll
  for (int r = 0; r < 16; ++r) tile[(r * 4 + (tid >> 6)) * 65 + (tid & 63)] = v[r];
  __syncthreads();
#pragma unroll
  for (int i = 0; i < 2; ++i) {
    const int nn = (tid >> 3) + 32 * i, kc = (tid & 7) * 8;
    u32x4 w;
    w.x = pk_bf16(tile[(kc + 0) * 65 + nn], tile[(kc + 1) * 65 + nn]);
    w.y = pk_bf16(tile[(kc + 2) * 65 + nn], tile[(kc + 3) * 65 + nn]);
    w.z = pk_bf16(tile[(kc + 4) * 65 + nn], tile[(kc + 5) * 65 + nn]);
    w.w = pk_bf16(tile[(kc + 6) * 65 + nn], tile[(kc + 7) * 65 + nn]);
    if (j.dst8) {
      u32x2 w8;
      w8.x = (unsigned)cvt4_fp8(32.f * tile[(kc + 0) * 65 + nn], 32.f * tile[(kc + 1) * 65 + nn], 32.f * tile[(kc + 2) * 65 + nn], 32.f * tile[(kc + 3) * 65 + nn]);
      w8.y = (unsigned)cvt4_fp8(32.f * tile[(kc + 4) * 65 + nn], 32.f * tile[(kc + 5) * 65 + nn], 32.f * tile[(kc + 6) * 65 + nn], 32.f * tile[(kc + 7) * 65 + nn]);
      *(u32x2*)(j.dst8 + (size_t)(j.n0 + nn) * 1024 + j.k0 + kc) = w8;
    } else {
      *(u32x4*)(j.dst + (size_t)(j.n0 + nn) * j.K + j.k0 + kc) = w;
    }
  }
  __syncthreads();
}

DI void phase0(const Params& p, char* lds) {
  int tid_ = threadIdx.x; asm volatile("" : "+v"(tid_));
  const int tid = tid_, G = gridDim.x, lane = tid & 63, wid = tid >> 6;
  float* tile = (float*)lds;
  int cum[9]; cum[0] = 0;
#pragma unroll
  for (int l = 0; l < 4; ++l) { const int kind = l % 3; cum[2 * l + 1] = cum[2 * l] + 16 * (nin_of(kind) / 64); cum[2 * l + 2] = cum[2 * l + 1] + (outw_of(kind) / 64) * 16; }
  const int total = cum[8];
  if ((int)blockIdx.x < total) {
    float va[16], vb[16];
    TJob ja = tj_decode(p, blockIdx.x, cum), jb{};
    tj_load(ja, va, tid);
    for (int job = blockIdx.x; job < total; job += 2 * G) {
      const bool hb = job + G < total, hc = job + 2 * G < total;
      if (hb) { jb = tj_decode(p, job + G, cum); tj_load(jb, vb, tid); }
      tj_store(ja, va, tile, tid);
      if (hc) { ja = tj_decode(p, job + 2 * G, cum); tj_load(ja, va, tid); }
      if (hb) tj_store(jb, vb, tile, tid);
    }
  }
  for (int r0 = blockIdx.x * 4 + wid; r0 < S; r0 += G * 16) {
    f32x4 v[4][4];
#pragma unroll
    for (int q = 0; q < 4; ++q) {
      const int r = r0 + q * G * 4;
      if (r < S) {
#pragma unroll
        for (int i = 0; i < 4; ++i) v[q][i] = *(const f32x4*)(p.x + (size_t)r * DM + i * 256 + lane * 4);
      }
    }
#pragma unroll
    for (int q = 0; q < 4; ++q) {
      const int r = r0 + q * G * 4;
      if (r < S) {
        float ss = 0.f;
#pragma unroll
        for (int i = 0; i < 4; ++i) {
          const f32x4 x4 = v[q][i];
          ss += x4.x * x4.x + x4.y * x4.y + x4.z * x4.z + x4.w * x4.w;
          u32x2 w; w.x = pk_bf16(x4.x, x4.y); w.y = pk_bf16(x4.z, x4.w);
          *(u32x2*)(p.xb + (size_t)r * DM + i * 256 + lane * 4) = w;
        }
#pragma unroll
        for (int o = 32; o >= 1; o >>= 1) ss += __shfl_xor(ss, o);
        if (lane == 0) p.rs[r] = ss;
        else if (lane < 4) p.rs[lane * S + r] = 0.f;
      }
    }
  }
  for (int gt = blockIdx.x * 256 + tid; gt < 320 * 16; gt += G * 256) {
    const int n = gt >> 4, m = gt & 15, nn = n < 256 ? n : n - 256;
    const double b = sqrt(sqrt(10.0));
    double pw = 1.0;
    for (int i = 0; i < m; ++i) pw *= b;
    const float freq = 1.0f / (float)pw;
    const float ang = (float)nn * freq;
    const double a = (double)ang;
    const double kq = rint(a * 0.15915494309189535);
    double r = fma(-kq, 6.283185307179586, a);
    r = fma(-kq, 2.4492935982947064e-16, r);
    const double r2 = r * r;
    double c = 1.0, s = r, tc = 1.0, ts = r;
    for (int q = 1; q <= 14; ++q) {
      tc *= -r2 / (double)((2 * q - 1) * (2 * q)); c += tc;
      ts *= -r2 / (double)((2 * q) * (2 * q + 1)); s += ts;
    }
    f32x2 o; o.x = (float)c; o.y = (float)s;
    p.rope[gt] = o;
  }
}

typedef int v8i __attribute__((ext_vector_type(8)));
#define MFMA8(a, b, c, bfmt) __builtin_amdgcn_mfma_scale_f32_32x32x64_f8f6f4((a), (b), (c), 0, (bfmt), 0, 0, 0, 0)
#define MFMA4(a, b, c) __builtin_amdgcn_mfma_scale_f32_32x32x64_f8f6f4((a), (b), (c), 4, 4, 0, 123, 0, 127)
DI v8i widen4(u32x4 a) { typedef int i4 __attribute__((ext_vector_type(4))); const i4 b = __builtin_bit_cast(i4, a); return __builtin_shufflevector(b, b, 0, 1, 2, 3, -1, -1, -1, -1); }
DI int off8(int row, int c) { return row * 64 + ((c ^ ((row >> 2) & 3)) << 4); }
DI v8i ld32(const char* p0, const char* p1) {
  const u32x4 a = *(const u32x4*)p0, b = *(const u32x4*)p1;
  v8i r; r[0] = a.x; r[1] = a.y; r[2] = a.z; r[3] = a.w; r[4] = b.x; r[5] = b.y; r[6] = b.z; r[7] = b.w; return r;
}

template <bool F8>
DI void gemm_tile(const bf16_t* __restrict__ A, const bf16_t* __restrict__ B, int K, int f0, int t0, char* lds, f32x16 (&acc)[2][2]) {
  int tid_ = threadIdx.x; asm volatile("" : "+v"(tid_));
  const int tid = tid_, lane = tid & 63, wid = tid >> 6, wm = wid >> 1, wn = wid & 1, l32 = lane & 31, h = lane >> 5;
  const int r0 = tid >> 3, c = tid & 7;
#pragma unroll
  for (int i = 0; i < 2; ++i)
#pragma unroll
    for (int j = 0; j < 2; ++j)
#pragma unroll
      for (int r = 0; r < 16; ++r) acc[i][j][r] = 0.f;
  const bf16_t* ag = A + (size_t)(f0 + r0) * K + c * 8;
  const bf16_t* bg = B + (size_t)(t0 + r0) * K + c * 8;
  const int nk = K >> 6;
  u32x4 R0[8], R1[8];
  auto gload = [&](u32x4 (&R)[8], int kt) {
#pragma unroll
    for (int i = 0; i < 4; ++i) { R[i] = *(const u32x4*)(ag + (size_t)(32 * i) * K + kt * 64); R[4 + i] = *(const u32x4*)(bg + (size_t)(32 * i) * K + kt * 64); }
  };
  auto lstore = [&](const u32x4 (&R)[8], int buf) {
    char* d = lds + buf * 32768;
#pragma unroll
    for (int i = 0; i < 4; ++i) { const int off = lds_off(r0 + 32 * i, c); *(u32x4*)(d + off) = R[i]; *(u32x4*)(d + 16384 + off) = R[4 + i]; }
  };
  auto step = [&](int kt, u32x4 (&Ra)[8], const u32x4 (&Rb)[8]) {
    if (kt + 2 < nk) gload(Ra, kt + 2);
    __builtin_amdgcn_sched_barrier(0);
    const char* a = lds + (kt & 1) * 32768;
    const char* b = a + 16384;
    if constexpr (F8) {
#pragma unroll
      for (int ks = 0; ks < 2; ++ks) {
        v8i a8[2], b8[2];
#pragma unroll
        for (int i = 0; i < 2; ++i) {
          a8[i] = ld32(a + lds_off(wm * 64 + i * 32 + l32, 4 * ks + 2 * h), a + lds_off(wm * 64 + i * 32 + l32, 4 * ks + 2 * h + 1));
          b8[i] = ld32(b + lds_off(wn * 64 + i * 32 + l32, 4 * ks + 2 * h), b + lds_off(wn * 64 + i * 32 + l32, 4 * ks + 2 * h + 1));
        }
        __builtin_amdgcn_sched_barrier(0);
#pragma unroll
        for (int i = 0; i < 2; ++i)
#pragma unroll
          for (int j = 0; j < 2; ++j) acc[i][j] = MFMA8(a8[i], b8[j], acc[i][j], 0);
        __builtin_amdgcn_sched_barrier(0);
      }
      if (kt + 1 < nk) lstore(Rb, (kt + 1) & 1);
      __syncthreads();
      return;
    }
    bf16x8 af[2][2], bf[2][2];
#pragma unroll
    for (int i = 0; i < 2; ++i) { af[0][i] = *(const bf16x8*)(a + lds_off(wm * 64 + i * 32 + l32, h)); bf[0][i] = *(const bf16x8*)(b + lds_off(wn * 64 + i * 32 + l32, h)); }
#pragma unroll
    for (int kk = 0; kk < 4; ++kk) {
      if (kk < 3) {
#pragma unroll
        for (int i = 0; i < 2; ++i) { af[(kk + 1) & 1][i] = *(const bf16x8*)(a + lds_off(wm * 64 + i * 32 + l32, 2 * (kk + 1) + h)); bf[(kk + 1) & 1][i] = *(const bf16x8*)(b + lds_off(wn * 64 + i * 32 + l32, 2 * (kk + 1) + h)); }
      }
      __builtin_amdgcn_sched_barrier(0);
#pragma unroll
      for (int i = 0; i < 2; ++i)
#pragma unroll
        for (int j = 0; j < 2; ++j) acc[i][j] = MFMA32(af[kk & 1][i], bf[kk & 1][j], acc[i][j]);
      __builtin_amdgcn_sched_barrier(0);
    }
    if (kt + 1 < nk) lstore(Rb, (kt + 1) & 1);
    __syncthreads();
  };
  gload(R0, 0);
  gload(R1, 1);
  __syncthreads();
  lstore(R0, 0);
  __syncthreads();
#pragma unroll 1
  for (int kt = 0; kt < nk; kt += 2) { step(kt, R0, R1); step(kt + 1, R1, R0); }
}

DI void phase_inproj(const Params& p, int l, char* lds) {
  const int kind = l % 3, NIN = nin_of(kind), NF = NIN / 128, QW = qw_of(kind), KVW = kvw_of(kind), OW = outw_of(kind);
  const int nqh = QW / 64, nkh = KVW / 64;
  int tid_ = threadIdx.x; asm volatile("" : "+v"(tid_));
  const int tid = tid_, lane = tid & 63, wid = tid >> 6, wm = wid >> 1, wn = wid & 1, l32 = lane & 31, h = lane >> 5;
  const float* rs = p.rs + l * S;
  const int ntiles = NF * (S / 128);
  for (int idx = blockIdx.x; idx < ntiles; idx += gridDim.x) {
    const int ti = idx / NF, fi = idx - ti * NF; int f0 = fi * 128, t0 = ti * 128;
    f32x16 acc[2][2];
    if (l == 1) gemm_tile<true>((const bf16_t*)p.wt8, (const bf16_t*)p.xb8, 512, f0, t0, lds, acc);
    else gemm_tile<false>(p.wt_in[l], p.xb, 1024, f0, t0, lds, acc);
    asm volatile("" : "+s"(t0), "+s"(f0));
    const int hb = (f0 >> 6) + wm;
    char* wl = lds + wid * 9216;
#pragma unroll
    for (int j = 0; j < 2; ++j) {
      const int t = t0 + wn * 64 + j * 32 + l32;
      const float rsc = __builtin_amdgcn_rsqf(rs[t] * (1.0f / 1024.0f) + EPS) * (l == 1 ? 0.03125f : 1.0f);
      float v[2][16];
#pragma unroll
      for (int i = 0; i < 2; ++i)
#pragma unroll
        for (int r = 0; r < 16; ++r) v[i][r] = acc[i][j][r] * rsc;
      if (hb < nqh + nkh) {
        const bool isq = hb < nqh;
        const float* gain = isq ? p.qg[l] : p.kg[l];
        float ss = 0.f;
#pragma unroll
        for (int i = 0; i < 2; ++i)
#pragma unroll
          for (int r = 0; r < 16; ++r) ss += v[i][r] * v[i][r];
        ss += __shfl_xor(ss, 32);
        const float nrm = __builtin_amdgcn_rsqf(ss * (1.0f / 64.0f) + EPS) * (isq ? 0.125f * LOG2E : 1.0f);
#pragma unroll
        for (int i = 0; i < 2; ++i)
#pragma unroll
          for (int g = 0; g < 4; ++g) {
            const f32x4 gv = *(const f32x4*)(gain + 32 * i + 8 * g + 4 * h);
            v[i][4 * g + 0] *= nrm * gv.x; v[i][4 * g + 1] *= nrm * gv.y; v[i][4 * g + 2] *= nrm * gv.z; v[i][4 * g + 3] *= nrm * gv.w;
          }
        if (kind == 1) {
#pragma unroll
          for (int i = 0; i < 2; ++i) {
            const f32x2* tab = p.rope + (i == 0 ? (t >> 6) : (256 + (t & 63))) * 16;
#pragma unroll
            for (int g = 0; g < 4; ++g)
#pragma unroll
              for (int e = 0; e < 2; ++e) {
                const f32x2 cs = tab[4 * g + 2 * h + e];
                const float x1 = v[i][4 * g + 2 * e], x2 = v[i][4 * g + 2 * e + 1];
                v[i][4 * g + 2 * e] = x1 * cs.x - x2 * cs.y;
                v[i][4 * g + 2 * e + 1] = x1 * cs.y + x2 * cs.x;
              }
          }
        }
        if (kind == 1) {
          const float mul = isq ? 8.f : 2.f;
          u32x4 w4;
#pragma unroll
          for (int i = 0; i < 2; ++i)
#pragma unroll
            for (int gp = 0; gp < 2; ++gp) {
              unsigned w = 0;
#pragma unroll
              for (int q = 0; q < 8; ++q) {
                const float x = v[i][8 * gp + q] * mul, ax = __builtin_fabsf(x);
                unsigned code = (ax > 0.25f) + (ax > 0.75f) + (ax > 1.25f) + (ax > 1.75f) + (ax > 2.5f) + (ax > 3.5f) + (ax > 5.0f);
                code |= x < 0.f ? 8u : 0u;
                w |= code << (4 * q);
              }
              w4[2 * i + gp] = w;
            }
          unsigned char* qk4 = isq ? (unsigned char*)p.Q + ((size_t)hb * S + t) * 32 : (unsigned char*)p.K + ((size_t)(hb - nqh) * S + t) * 32;
          *(u32x4*)(qk4 + h * 16) = w4;
        } else {
#pragma unroll
          for (int i = 0; i < 2; ++i)
#pragma unroll
            for (int g = 0; g < 4; ++g) {
              u32x2 w; w.x = pk_bf16(v[i][4 * g], v[i][4 * g + 1]); w.y = pk_bf16(v[i][4 * g + 2], v[i][4 * g + 3]);
              *(u32x2*)(wl + (j * 32 + l32) * 144 + (32 * i + 8 * g + 4 * h) * 2) = w;
            }
        }
      } else if (hb < nqh + 2 * nkh) {
        if (kind == 1) {
#pragma unroll
          for (int i = 0; i < 2; ++i)
#pragma unroll
            for (int r = 0; r < 16; ++r) {
              const int d = 32 * i + 8 * (r >> 2) + 4 * h + (r & 3);
              *(unsigned char*)(wl + d * 68 + j * 32 + l32) = (unsigned char)(__builtin_amdgcn_cvt_pk_fp8_f32(v[i][r], v[i][r], 0, false) & 0xff);
            }
        } else
#pragma unroll
        for (int i = 0; i < 2; ++i)
#pragma unroll
          for (int r = 0; r < 16; r += 2) {
            const unsigned w = pk_bf16(v[i][r], v[i][r + 1]);
            const int d = 32 * i + 8 * (r >> 2) + 4 * h + (r & 3);
            *(bf16_t*)(wl + d * 132 + (j * 32 + l32) * 2) = (bf16_t)(w & 0xffff);
            *(bf16_t*)(wl + (d + 1) * 132 + (j * 32 + l32) * 2) = (bf16_t)(w >> 16);
          }
      } else {
#pragma unroll
        for (int i = 0; i < 2; ++i)
#pragma unroll
          for (int g = 0; g < 4; ++g) {
            float s4[4];
#pragma unroll
            for (int e = 0; e < 4; ++e) { const float u = v[i][4 * g + e]; s4[e] = u * __builtin_amdgcn_rcpf(1.0f + __builtin_amdgcn_exp2f(-u * LOG2E)); }
            u32x2 w; w.x = pk_bf16(s4[0], s4[1]); w.y = pk_bf16(s4[2], s4[3]);
            *(u32x2*)(wl + (j * 32 + l32) * 144 + (32 * i + 8 * g + 4 * h) * 2) = w;
          }
      }
    }
    const int tb = t0 + wn * 64;
    if (kind == 1 && hb < nqh + 2 * nkh) {
      if (hb < nqh + nkh) {
      } else {
        unsigned char* vbase = (unsigned char*)p.Vt + ((size_t)(hb - nqh - nkh) * 256 + (tb >> 6)) * 4096;
#pragma unroll
        for (int ps = 0; ps < 4; ++ps) {
          const int id = ps * 64 + lane, d = id >> 2, cq = id & 3, hh = cq >> 1, mq = cq & 1;
          const char* src = wl + d * 68 + 32 * mq + 4 * hh;
          u32x4 val; val.x = *(const unsigned*)(src); val.y = *(const unsigned*)(src + 8); val.z = *(const unsigned*)(src + 16); val.w = *(const unsigned*)(src + 24);
          *(u32x4*)(vbase + d * 64 + 16 * cq) = val;
        }
      }
    } else if (hb >= nqh + nkh && hb < nqh + 2 * nkh) {
      const int slot = hb - nqh - nkh;
      const int dsh = kind == 2 ? 2 * (slot >> 1) : 0, dil = 1 << dsh;
      bf16_t* vbase = p.Vt + (size_t)slot * 64 * S;
#pragma unroll 4
      for (int ps = 0; ps < 16; ++ps) {
        const int u = ps * 64 + lane, d = u >> 4, m = u & 15, c = m & (dil - 1), kq = m >> dsh;
        const char* src = wl + d * 132 + (c + dil * 4 * kq) * 2;
        const unsigned a0 = *(const bf16_t*)(src), a1 = *(const bf16_t*)(src + dil * 2), a2 = *(const bf16_t*)(src + dil * 4), a3 = *(const bf16_t*)(src + dil * 6);
        u32x2 w; w.x = a0 | (a1 << 16); w.y = a2 | (a3 << 16);
        const int pi = (c << (14 - dsh)) + (tb >> dsh) + 4 * kq;
        const int lo = pi & 15, pos = (pi & ~15) | (lo & 3) | (((lo >> 2) & 1) << 3) | (((lo >> 3) & 1) << 2);
        *(u32x2*)(vbase + (size_t)(pos >> 6) * 4096 + d * 64 + (pos & 63)) = w;
      }
    } else {
      bf16_t* dbase; size_t pitch;
      if (hb < nqh) { dbase = p.Q + (size_t)tb * QW + hb * 64; pitch = QW; }
      else if (hb < nqh + nkh) { dbase = p.K + ((size_t)(hb - nqh) * S + tb) * 64; pitch = 64; }
      else { dbase = p.SG + (size_t)tb * OW + (hb - nqh - 2 * nkh) * 64; pitch = OW; }
#pragma unroll
      for (int ps = 0; ps < 8; ++ps) {
        const int row = ps * 8 + (lane >> 3), ch = lane & 7;
        const u32x4 val = *(const u32x4*)(wl + row * 144 + ch * 16);
        *(u32x4*)(dbase + (size_t)row * pitch + ch * 8) = val;
      }
    }
  }
}

DI void phase_outproj(const Params& p, int l, char* lds, bool dry = false) {
  const int kind = l % 3, OW = outw_of(kind);
  int tid_ = threadIdx.x; asm volatile("" : "+v"(tid_));
  const int tid = tid_, lane = tid & 63, wid = tid >> 6, wm = wid >> 1, wn = wid & 1, l32 = lane & 31, h = lane >> 5;
  const float* xres = l == 0 ? p.x : p.out;
  float* rsn = p.rs + (l + 1) * S;
  const int ntiles = 8 * (S / 128);
  for (int idx = blockIdx.x; idx < ntiles; idx += gridDim.x) {
    const int ti = idx >> 3, fi = idx & 7; int f0 = fi * 128, t0 = ti * 128;
    f32x16 acc[2][2];
    if (l == 1) gemm_tile<true>((const bf16_t*)p.wo8, (const bf16_t*)p.og8, 512, f0, t0, lds, acc);
    else gemm_tile<false>(p.wt_out[l], p.OG, OW, f0, t0, lds, acc);
    asm volatile("" : "+s"(t0), "+s"(f0));
    char* wl = lds + wid * 8704;
#pragma unroll
    for (int j = 0; j < 2; ++j) {
#pragma unroll
      for (int i = 0; i < 2; ++i)
#pragma unroll
        for (int g = 0; g < 4; ++g) {
          f32x4 a; a.x = acc[i][j][4 * g]; a.y = acc[i][j][4 * g + 1]; a.z = acc[i][j][4 * g + 2]; a.w = acc[i][j][4 * g + 3];
          *(f32x4*)(wl + l32 * 272 + (32 * i + 8 * g + 4 * h) * 4) = a;
        }
#pragma unroll
      for (int ps = 0; ps < 8; ++ps) {
        const int row = ps * 4 + (lane >> 4), ch = lane & 15;
        f32x4 a = *(const f32x4*)(wl + row * 272 + ch * 16);
        if (l == 1) { a.x *= (1.0f / 2048.0f); a.y *= (1.0f / 2048.0f); a.z *= (1.0f / 2048.0f); a.w *= (1.0f / 2048.0f); }
        const int t = t0 + wn * 64 + j * 32 + row;
        const size_t o = (size_t)t * DM + f0 + wm * 64 + ch * 4;
        f32x4 xv = *(const f32x4*)(xres + o);
        xv.x += a.x; xv.y += a.y; xv.z += a.z; xv.w += a.w;
        *(f32x4*)(p.out + o) = xv;
        if (l < 3) {
          if (l == 0) { *(int*)(p.xb8 + o) = cvt4_fp8(xv.x, xv.y, xv.z, xv.w); }
          else { u32x2 w; w.x = pk_bf16(xv.x, xv.y); w.y = pk_bf16(xv.z, xv.w); *(u32x2*)(p.xb + o) = w; }
          float ss = xv.x * xv.x + xv.y * xv.y + xv.z * xv.z + xv.w * xv.w;
          ss += __shfl_xor(ss, 1); ss += __shfl_xor(ss, 2); ss += __shfl_xor(ss, 4); ss += __shfl_xor(ss, 8);
          if (ch == 0 && !dry) atomicAdd(rsn + t, ss);
        }
      }
    }
  }
}

template <bool MASKED>
DI void attn_group(const bf16_t* __restrict__ Qp, int qld, const bf16_t* __restrict__ Kp, int kld, const bf16_t* __restrict__ Vtp,
                   int T0, int qs, int dsh, int W, float slope_c, float sc, float Mc, f32x16 (&oacc)[2], float& lsum, char* lds) {
  int tid_ = threadIdx.x; asm volatile("" : "+v"(tid_));
  const int tid = tid_, lane = tid & 63, wid = tid >> 6, l32 = lane & 31, h = lane >> 5;
  const int dil = 1 << dsh, L = S >> dsh, c_d = T0 & (dil - 1), U0 = T0 >> dsh;
  const int tq = T0 + qs * (wid * 32 + l32);
  const int tq_lo = T0 + qs * (wid * 32), tq_hi = tq_lo + qs * 31;
  bf16x8 qf[4];
#pragma unroll
  for (int kk = 0; kk < 4; ++kk) qf[kk] = *(const bf16x8*)(Qp + (size_t)tq * qld + 16 * kk + 8 * h);
  int Ub = 0, Ue = S;
  if (MASKED) {
    const int Wd = W >> dsh, lo = U0 - Wd, hi = U0 + (qs >> dsh) * 127 + Wd + 1;
    Ub = lo < 0 ? 0 : (lo & ~63);
    Ue = hi < L ? hi : L;
  }
  const int ntiles = (Ue - Ub + 63) >> 6;
  const int r0 = tid >> 3, c = tid & 7;
  const bf16_t* kg = Kp + (size_t)(c_d + dil * (Ub + r0)) * kld + c * 8;
  const size_t kstep32 = (size_t)(dil * 32) * kld, kstep64 = (size_t)(dil * 64) * kld;
  const bf16_t* vg = Vtp + (size_t)((c_d * L + Ub) >> 6) * 4096 + r0 * 64 + c * 8;
  u32x4 R0[4], R1[4];
  auto gload = [&](u32x4 (&R)[4], int t) {
#pragma unroll
    for (int i = 0; i < 2; ++i) { R[i] = *(const u32x4*)(kg + t * kstep64 + i * kstep32); R[2 + i] = *(const u32x4*)(vg + 2048 * i + (size_t)t * 4096); }
  };
  auto lstore = [&](const u32x4 (&R)[4], int buf) {
    char* d = lds + buf * 16384;
#pragma unroll
    for (int i = 0; i < 2; ++i) { const int off = lds_off(r0 + 32 * i, c); *(u32x4*)(d + off) = R[i]; *(u32x4*)(d + 8192 + off) = R[2 + i]; }
  };
  auto step = [&](int t, u32x4 (&Ra)[4], const u32x4 (&Rb)[4]) {
    if (t + 2 < ntiles) gload(Ra, t + 2);
    __builtin_amdgcn_sched_barrier(0);
    const int tile_tok0 = c_d + dil * (Ub + 64 * t);
    bool active = true;
    if (MASKED) active = !(tile_tok0 > tq_hi + W || tile_tok0 + dil * 63 < tq_lo - W);
    if (active) {
      const char* kb = lds + (t & 1) * 16384;
      const char* vb = kb + 8192;
      f32x16 sacc[2];
#pragma unroll
      for (int kt = 0; kt < 2; ++kt)
#pragma unroll
        for (int r = 0; r < 16; ++r) sacc[kt][r] = -Mc;
      bf16x8 kf[2][4];
#pragma unroll
      for (int kk = 0; kk < 4; ++kk)
#pragma unroll
        for (int kt = 0; kt < 2; ++kt) kf[kt][kk] = *(const bf16x8*)(kb + lds_off(32 * kt + l32, 2 * kk + h));
      __builtin_amdgcn_sched_barrier(0);
#pragma unroll
      for (int kk = 0; kk < 4; ++kk)
#pragma unroll
        for (int kt = 0; kt < 2; ++kt) sacc[kt] = MFMA32(kf[kt][kk], qf[kk], sacc[kt]);
      bf16x8 vf[4][2];
#pragma unroll
      for (int s = 0; s < 4; ++s)
#pragma unroll
        for (int i = 0; i < 2; ++i) vf[s][i] = *(const bf16x8*)(vb + lds_off(32 * i + l32, 2 * s + h));
      __builtin_amdgcn_sched_barrier(0);
      if (MASKED) {
        const float Wf = (float)W, ndil = -(float)dil;
        const float nd1 = __uint_as_float(__builtin_amdgcn_readfirstlane(__float_as_uint(ndil)));
        const float nd2 = __uint_as_float(__builtin_amdgcn_readfirstlane(__float_as_uint(2.f * ndil)));
        const float nd3 = __uint_as_float(__builtin_amdgcn_readfirstlane(__float_as_uint(3.f * ndil)));
        const float nd8 = __uint_as_float(__builtin_amdgcn_readfirstlane(__float_as_uint(8.f * ndil)));
        float dg = (float)(tq - tile_tok0 - dil * 4 * h);
#pragma unroll
        for (int kt = 0; kt < 2; ++kt)
#pragma unroll
          for (int g = 0; g < 4; ++g) {
            const float d4[4] = {dg, dg + nd1, dg + nd2, dg + nd3};
#pragma unroll
            for (int e = 0; e < 4; ++e) {
              const float ex = __builtin_amdgcn_exp2f(__builtin_fmaf(-slope_c, __builtin_fabsf(d4[e]), sacc[kt][4 * g + e]));
              const float pv = __builtin_fabsf(d4[e]) <= Wf ? ex : 0.f;
              lsum += pv;
              sacc[kt][4 * g + e] = pv;
            }
            dg += nd8;
          }
      } else {
#pragma unroll
        for (int kt = 0; kt < 2; ++kt)
#pragma unroll
          for (int r = 0; r < 16; ++r) { const float pv = __builtin_amdgcn_exp2f(sacc[kt][r]); lsum += pv; sacc[kt][r] = pv; }
      }
#pragma unroll
      for (int s = 0; s < 4; ++s) {
        u32x4 pw;
        const int kt = s >> 1, b = 8 * (s & 1);
        pw.x = pk_bf16(sacc[kt][b + 0], sacc[kt][b + 1]); pw.y = pk_bf16(sacc[kt][b + 2], sacc[kt][b + 3]);
        pw.z = pk_bf16(sacc[kt][b + 4], sacc[kt][b + 5]); pw.w = pk_bf16(sacc[kt][b + 6], sacc[kt][b + 7]);
        const bf16x8 pf = __builtin_bit_cast(bf16x8, pw);
#pragma unroll
        for (int i = 0; i < 2; ++i) oacc[i] = MFMA32(vf[s][i], pf, oacc[i]);
      }
    }
    __builtin_amdgcn_sched_barrier(0);
    if (t + 1 < ntiles) lstore(Rb, (t + 1) & 1);
    __syncthreads();
  };
  gload(R0, 0);
  if (ntiles > 1) gload(R1, 1);
  lstore(R0, 0);
  __syncthreads();
#pragma unroll 1
  for (int t = 0; t < ntiles; t += 2) { step(t, R0, R1); if (t + 1 < ntiles) step(t + 1, R1, R0); }
}


DI void attn_dense_fast(const bf16_t* __restrict__ Qp, const bf16_t* __restrict__ Kp, const bf16_t* __restrict__ Vtp, int T0,
                        f32x16 (&oacc)[2], float& lsum, char* lds) {
  int tid_ = threadIdx.x; asm volatile("" : "+v"(tid_));
  const int tid = tid_, lane = tid & 63, wid = tid >> 6, l32 = lane & 31, h = lane >> 5;
  const int tq = T0 + wid * 32 + l32;
  bf16x8 qf[4];
#pragma unroll
  for (int kk = 0; kk < 4; ++kk) qf[kk] = *(const bf16x8*)(Qp + (size_t)tq * 1024 + 16 * kk + 8 * h);
  const int r0 = tid >> 3, c = tid & 7;
  const bf16_t* kg = Kp + (size_t)r0 * 64 + c * 8;
  const bf16_t* vg = Vtp + r0 * 64 + c * 8;
  constexpr int n = S / 64;
  u32x4 R0[4], R1[4];
  auto gload = [&](u32x4 (&R)[4], int t) {
#pragma unroll
    for (int i = 0; i < 2; ++i) { R[i] = *(const u32x4*)(kg + (size_t)(t * 64 + 32 * i) * 64); R[2 + i] = *(const u32x4*)(vg + 2048 * i + (size_t)t * 4096); }
  };
  auto lstore = [&](const u32x4 (&R)[4], int buf) {
    char* d = lds + buf * 16384;
#pragma unroll
    for (int i = 0; i < 2; ++i) { const int off = lds_off(r0 + 32 * i, c); *(u32x4*)(d + off) = R[i]; *(u32x4*)(d + 8192 + off) = R[2 + i]; }
  };
  int koff[4], voff[2][2];
#pragma unroll
  for (int kk = 0; kk < 4; ++kk) koff[kk] = lds_off(l32, 2 * kk + h);
  f32x16 SA, SB;
  float ls0 = 0.f, ls1 = 0.f;
  bf16x8 kf[4];
  bf16x8 vf[2][2];
  bf16x8 pf[2];
#define FENCE() __builtin_amdgcn_sched_barrier(0)
#define EX(i) pv[i] = __builtin_amdgcn_exp2f(Sc[i])
  auto half = [&](const f32x16& Sc, f32x16& Sn, const char* knext, const char* vcur, int hv) {
    f32x16 z;
#pragma unroll
    for (int r = 0; r < 16; ++r) z[r] = 0.f;
    float pv[16];
    u32x4 pw0, pw1;
    const int vo00 = lds_off(l32, 2 * (2 * hv) + h), vo01 = lds_off(32 + l32, 2 * (2 * hv) + h);
    const int vo10 = lds_off(l32, 2 * (2 * hv + 1) + h), vo11 = lds_off(32 + l32, 2 * (2 * hv + 1) + h);
    FENCE();
    Sn = MFMA32(kf[0], qf[0], z);               kf[0] = *(const bf16x8*)(knext + koff[0]);  EX(0); EX(1); EX(2);      FENCE();
    oacc[0] = MFMA32(vf[0][0], pf[0], oacc[0]); vf[0][0] = *(const bf16x8*)(vcur + vo00);   EX(3); EX(4); EX(5);      FENCE();
    Sn = MFMA32(kf[1], qf[1], Sn);              kf[1] = *(const bf16x8*)(knext + koff[1]);  EX(6); EX(7); EX(8);      FENCE();
    oacc[1] = MFMA32(vf[0][1], pf[0], oacc[1]); vf[0][1] = *(const bf16x8*)(vcur + vo01);   EX(9); EX(10); EX(11);    FENCE();
    Sn = MFMA32(kf[2], qf[2], Sn);              kf[2] = *(const bf16x8*)(knext + koff[2]);  EX(12); EX(13); EX(14); EX(15); FENCE();
    oacc[0] = MFMA32(vf[1][0], pf[1], oacc[0]); vf[1][0] = *(const bf16x8*)(vcur + vo10);
    pw0.x = pk_bf16(pv[0], pv[1]); pw0.y = pk_bf16(pv[2], pv[3]); pw0.z = pk_bf16(pv[4], pv[5]); pw0.w = pk_bf16(pv[6], pv[7]);
    ls0 += pv[0]; ls1 += pv[1];                                                                                        FENCE();
    Sn = MFMA32(kf[3], qf[3], Sn);              kf[3] = *(const bf16x8*)(knext + koff[3]);
    pw1.x = pk_bf16(pv[8], pv[9]); pw1.y = pk_bf16(pv[10], pv[11]); pw1.z = pk_bf16(pv[12], pv[13]); pw1.w = pk_bf16(pv[14], pv[15]);
    ls0 += pv[2]; ls1 += pv[3];                                                                                        FENCE();
    oacc[1] = MFMA32(vf[1][1], pf[1], oacc[1]); vf[1][1] = *(const bf16x8*)(vcur + vo11);
    ls0 += pv[4]; ls1 += pv[5]; ls0 += pv[6]; ls1 += pv[7]; ls0 += pv[8]; ls1 += pv[9]; ls0 += pv[10]; ls1 += pv[11]; ls0 += pv[12]; ls1 += pv[13]; ls0 += pv[14]; ls1 += pv[15];
    asm volatile("" : "+v"(ls0), "+v"(ls1));
    FENCE();
    pf[0] = __builtin_bit_cast(bf16x8, pw0); pf[1] = __builtin_bit_cast(bf16x8, pw1);
  };
  gload(R0, 0);
  gload(R1, 1);
  lstore(R0, 0);
  lstore(R1, 1);
  gload(R0, 2);
  __syncthreads();
  {
    f32x16 z;
#pragma unroll
    for (int r = 0; r < 16; ++r) z[r] = 0.f;
    SA = z;
#pragma unroll
    for (int kk = 0; kk < 4; ++kk) SA = MFMA32(*(const bf16x8*)(lds + koff[kk]), qf[kk], SA);
#pragma unroll
    for (int kk = 0; kk < 4; ++kk) kf[kk] = *(const bf16x8*)(lds + 4096 + koff[kk]);
    const u32x4 zz = {0u, 0u, 0u, 0u};
    pf[0] = __builtin_bit_cast(bf16x8, zz); pf[1] = pf[0];
#pragma unroll
    for (int s = 0; s < 2; ++s)
#pragma unroll
      for (int i = 0; i < 2; ++i) vf[s][i] = *(const bf16x8*)(lds + 8192 + lds_off(32 * i + l32, 2 * s + h));
  }
  int bcur = 0;
  auto tile = [&](int t, u32x4 (&Rload)[4], const u32x4 (&Rstore)[4]) {
    if (t + 3 < n) gload(Rload, t + 3);
    FENCE();
    const int bnext = bcur == 2 ? 0 : bcur + 1, bwr = bnext == 2 ? 0 : bnext + 1;
    const char* cur = lds + bcur * 16384;
    const char* nxt = lds + bnext * 16384;
    half(SA, SB, nxt, cur + 8192, 0);
    half(SB, SA, nxt + 4096, cur + 8192, 1);
    if (t + 2 < n) lstore(Rstore, bwr);
    bcur = bnext;
    __syncthreads();
  };
#pragma unroll 1
  for (int t = 0; t < n; t += 2) { tile(t, R1, R0); tile(t + 1, R0, R1); }
#pragma unroll
  for (int s = 0; s < 2; ++s)
#pragma unroll
    for (int i = 0; i < 2; ++i) oacc[i] = MFMA32(vf[s][i], pf[s], oacc[i]);
  lsum += ls0 + ls1;
}


template <bool SHIFTED>
DI void attn_dense_fp8(const unsigned char* __restrict__ Qp, const unsigned char* __restrict__ Kp, const unsigned char* __restrict__ Vp, int T0, float shift,
                       f32x16 (&oacc)[2], float& lsum, char* lds) {
  int tid_ = threadIdx.x; asm volatile("" : "+v"(tid_));
  const int tid = tid_, lane = tid & 63, wid = tid >> 6, l32 = lane & 31, h = lane >> 5;
  const int tq = T0 + wid * 32 + l32;
  const v8i qf = widen4(*(const u32x4*)(Qp + (size_t)tq * 32 + h * 16));
  const int lr = tid >> 2, lc = (tid & 3) ^ ((lr >> 2) & 3);
  const unsigned goff = (unsigned)(lr * 64 + lc * 16);
#define kg (Kp + goff)
#define vg (Vp + goff)
  constexpr int n = S / 64;
  const int kP = (wid & 1) * 64 + lane, krow = kP >> 1, kc = (kP & 1) ^ ((krow >> 3) & 1);
  const unsigned koff4 = (unsigned)(krow * 32 + kc * 16);
  int fo4[2];
#pragma unroll
  for (int x = 0; x < 2; ++x) fo4[x] = (32 * x + l32) * 32 + ((h ^ ((l32 >> 3) & 1)) << 4);
  int fo[2][2];
#pragma unroll
  for (int x = 0; x < 2; ++x) { fo[x][0] = off8(32 * x + l32, 2 * h); fo[x][1] = off8(32 * x + l32, 2 * h + 1); }
  f32x16 zs;
#pragma unroll
  for (int r = 0; r < 16; ++r) zs[r] = 0.f;
  f32x16 SA[2], SB[2];
  v8i kf[2], vf[2], pf;
  float ls0 = 0.f, ls1 = 0.f;
#define FENCE() __builtin_amdgcn_sched_barrier(0)
#define EXA(i) pa[i] = __builtin_amdgcn_exp2f(SHIFTED ? Sc[0][i] - shift : Sc[0][i])
#define EXB(i) pb[i] = __builtin_amdgcn_exp2f(SHIFTED ? Sc[1][i] - shift : Sc[1][i])
  auto tile = [&](const f32x16 (&Sc)[2], f32x16 (&Sn)[2], const char* k2, const char* v0) {
    float pa[16], pb[16];
    FENCE();
    Sn[0] = MFMA4(kf[0], qf, zs);
    EXA(0); EXA(1); EXA(2); EXA(3); EXA(4); EXA(5); EXA(6); EXA(7); EXA(8); EXA(9); EXA(10);                     FENCE();
    oacc[0] = MFMA8(vf[0], pf, oacc[0], 1);     kf[0] = widen4(*(const u32x4*)(k2 + fo4[0]));
    EXA(11); EXA(12); EXA(13); EXA(14); EXA(15); EXB(0); EXB(1); EXB(2); EXB(3); EXB(4); EXB(5);
    v8i pn;
#pragma unroll
    for (int w = 0; w < 4; ++w) pn[w] = cvt4_bf8(pa[4 * w], pa[4 * w + 1], pa[4 * w + 2], pa[4 * w + 3]);
#pragma unroll
    for (int r = 0; r < 16; r += 2) { ls0 += pa[r]; ls1 += pa[r + 1]; }
    asm volatile("" : "+v"(ls0), "+v"(ls1));                                                                    FENCE();
    Sn[1] = MFMA4(kf[1], qf, zs);               vf[0] = ld32(v0 + fo[0][0], v0 + fo[0][1]);
    EXB(6); EXB(7); EXB(8); EXB(9); EXB(10); EXB(11); EXB(12); EXB(13); EXB(14); EXB(15);                         FENCE();
    oacc[1] = MFMA8(vf[1], pf, oacc[1], 1);     kf[1] = widen4(*(const u32x4*)(k2 + fo4[1]));
    FENCE();
    vf[1] = ld32(v0 + fo[1][0], v0 + fo[1][1]);
#pragma unroll
    for (int w = 0; w < 4; ++w) pn[4 + w] = cvt4_bf8(pb[4 * w], pb[4 * w + 1], pb[4 * w + 2], pb[4 * w + 3]);
#pragma unroll
    for (int r = 0; r < 16; r += 2) { ls0 += pb[r]; ls1 += pb[r + 1]; }
    asm volatile("" : "+v"(ls0), "+v"(ls1));
    FENCE();
    pf = pn;
  };
  auto tbase = [&](int k) { return ((k >> 1) & 3) * 16384 + (k & 1) * 8192; };
  auto dmat = [&](int k) {
    char* d = lds + tbase(k);
    glds16(Vp + (size_t)k * 4096 + goff, d + 4096 + tid * 16);
    glds16(Kp + (size_t)k * 2048 + koff4, d + kP * 16);
  };
  dmat(0); dmat(1); dmat(2); dmat(3); dmat(4); dmat(5);
  asm volatile("s_waitcnt vmcnt(0)" ::: "memory");
  __builtin_amdgcn_s_barrier();
  {
    kf[0] = widen4(*(const u32x4*)(lds + fo4[0])); kf[1] = widen4(*(const u32x4*)(lds + fo4[1]));
    SA[0] = MFMA4(kf[0], qf, zs); SA[1] = MFMA4(kf[1], qf, zs);
    kf[0] = widen4(*(const u32x4*)(lds + 8192 + fo4[0])); kf[1] = widen4(*(const u32x4*)(lds + 8192 + fo4[1]));
    vf[0] = ld32(lds + 4096 + fo[0][0], lds + 4096 + fo[0][1]); vf[1] = ld32(lds + 4096 + fo[1][0], lds + 4096 + fo[1][1]);
#pragma unroll
    for (int w = 0; w < 8; ++w) pf[w] = 0;
  }
#pragma unroll 1
  for (int t8 = 0; t8 < n; t8 += 8) {
#pragma unroll
    for (int u = 0; u < 4; ++u) {
      const int t = t8 + 2 * u;
      const bool more = t + 6 < n;
      if (more) {
        char* d = lds + ((u + 3) & 3) * 16384;
        glds16(Vp + (size_t)(t + 6) * 4096 + goff, d + 4096 + tid * 16);
        glds16(Vp + (size_t)(t + 7) * 4096 + goff, d + 8192 + 4096 + tid * 16);
        glds16(Kp + (size_t)(t + 6) * 2048 + koff4, d + kP * 16); glds16(Kp + (size_t)(t + 7) * 2048 + koff4, d + 8192 + kP * 16);
      }
      tile(SA, SB, lds + ((u + 1) & 3) * 16384, lds + u * 16384 + 4096);
      tile(SB, SA, lds + ((u + 1) & 3) * 16384 + 8192, lds + u * 16384 + 8192 + 4096);
      if (more) asm volatile("s_waitcnt vmcnt(4) lgkmcnt(0)" ::: "memory");
      else asm volatile("s_waitcnt vmcnt(0) lgkmcnt(0)" ::: "memory");
      __builtin_amdgcn_s_barrier();
    }
  }
  oacc[0] = MFMA8(vf[0], pf, oacc[0], 1);
  oacc[1] = MFMA8(vf[1], pf, oacc[1], 1);
  lsum += ls0 + ls1;
#undef EXA
#undef EXB
#undef kg
#undef vg
}

DI float gain_bound(const float* qg, const float* kg) {
  float a = 0.f, b = 0.f;
  for (int i = 0; i < 64; ++i) { a = fmaxf(a, fabsf(qg[i])); b = fmaxf(b, fabsf(kg[i])); }
  return 8.0f * a * b;
}

template <bool F8>
DI void attn_store(const Params& p, const f32x16 (&oacc)[2], float ltot, int t, int OW, int ocol) {
  const int h = (threadIdx.x & 63) >> 5;
  const float inv = (F8 ? 64.0f : 1.0f) / ltot;
#pragma unroll
  for (int i = 0; i < 2; ++i)
#pragma unroll
    for (int g = 0; g < 4; ++g) {
      const size_t o = (size_t)t * OW + ocol + 32 * i + 8 * g + 4 * h;
      const u32x2 sg = *(const u32x2*)(p.SG + o);
      u32x2 w;
      w.x = pk_bf16(oacc[i][4 * g] * inv * bf_lo(sg.x), oacc[i][4 * g + 1] * inv * bf_hi(sg.x));
      w.y = pk_bf16(oacc[i][4 * g + 2] * inv * bf_lo(sg.y), oacc[i][4 * g + 3] * inv * bf_hi(sg.y));
      if (F8) *(int*)(p.og8 + o) = cvt4_fp8(oacc[i][4 * g] * inv * bf_lo(sg.x), oacc[i][4 * g + 1] * inv * bf_hi(sg.x), oacc[i][4 * g + 2] * inv * bf_lo(sg.y), oacc[i][4 * g + 3] * inv * bf_hi(sg.y));
      else *(u32x2*)(p.OG + o) = w;
    }
}

DI void phase_attn(const Params& p, int l, char* lds) {
  const int kind = l % 3;
  const int tid = threadIdx.x, lane = tid & 63, wid = tid >> 6, l32 = lane & 31;
  const float bound = gain_bound(p.qg[l], p.kg[l]);
  const float sc = 0.125f * LOG2E;
  if (kind == 0) {
    for (int idx = blockIdx.x; idx < 16 * 128; idx += gridDim.x) {
      const int head = idx & 15, qt = idx >> 4, T0 = qt * 128;
      const float sk = p.sink[l][head], M = fmaxf(bound, sk);
      const float slope = exp2f(-0.5f * (float)(head + 1));
      f32x16 oacc[2]; float lsum = 0.f;
#pragma unroll
      for (int i = 0; i < 2; ++i)
#pragma unroll
        for (int r = 0; r < 16; ++r) oacc[i][r] = 0.f;
      attn_group<true>(p.Q + head * 64, 1024, p.K + (size_t)(head >> 2) * S * 64, 64, p.Vt + (size_t)(head >> 2) * 64 * S, T0, 1, 0, 128, slope * LOG2E, sc, M * LOG2E, oacc, lsum, lds);
      float ltot = lsum + __shfl_xor(lsum, 32);
      ltot += __builtin_amdgcn_exp2f((sk - M) * LOG2E);
      attn_store<false>(p, oacc, ltot, T0 + wid * 32 + l32, 1024, head * 64);
    }
  } else if (kind == 1) {
    for (int idx = blockIdx.x; idx < 16 * 128; idx += gridDim.x) {
      const int kvh = (idx & 7) >> 1, rest = ((idx >> 3) << 1) | (idx & 1), head = kvh * 4 + (rest & 3), qt = rest >> 2, T0 = qt * 128;
      f32x16 oacc[2]; float lsum = 0.f;
#pragma unroll
      for (int i = 0; i < 2; ++i)
#pragma unroll
        for (int r = 0; r < 16; ++r) oacc[i][r] = 0.f;
      const float Mc = bound * LOG2E;
      if (Mc > 14.f) attn_dense_fp8<true>((const unsigned char*)p.Q + (size_t)head * S * 32, (const unsigned char*)p.K + (size_t)kvh * S * 32, (const unsigned char*)p.Vt + (size_t)kvh * 64 * S, T0, Mc - 14.f, oacc, lsum, lds);
      else attn_dense_fp8<false>((const unsigned char*)p.Q + (size_t)head * S * 32, (const unsigned char*)p.K + (size_t)kvh * S * 32, (const unsigned char*)p.Vt + (size_t)kvh * 64 * S, T0, 0.f, oacc, lsum, lds);
      const float ltot = lsum + __shfl_xor(lsum, 32);
      attn_store<true>(p, oacc, ltot, T0 + wid * 32 + l32, 1024, head * 64);
    }
  } else {
    for (int idx = blockIdx.x; idx < 8 * 128; idx += gridDim.x) {
      const int slot = idx & 7, set = idx >> 3, T0 = (set >> 4) * 2048 + (set & 15);
      f32x16 oacc[2]; float lsum = 0.f;
#pragma unroll
      for (int i = 0; i < 2; ++i)
#pragma unroll
        for (int r = 0; r < 16; ++r) oacc[i][r] = 0.f;
      for (int gi = 0; gi < 3; ++gi) {
        const int head = gi * 8 + slot, kvs = gi * 2 + (slot >> 2), dsh = 2 * gi, W = 64 << dsh;
        const float slope = exp2f(-8.0f * (float)(head + 1) / 24.0f);
        attn_group<true>(p.Q + head * 64, 1536, p.K + (size_t)kvs * S * 64, 64, p.Vt + (size_t)kvs * 64 * S, T0, 16, dsh, W, slope * LOG2E, sc, bound * LOG2E, oacc, lsum, lds);
      }
      const float ltot = lsum + __shfl_xor(lsum, 32);
      attn_store<false>(p, oacc, ltot, T0 + 16 * (wid * 32 + l32), 512, slot * 64);
    }
  }
}


#define XB_TMO      128
#define XB_XCNT(j)  (256  + 64 * (j))
#define XB_XSUB(j)  (1280 + 64 * (j))
#define XB_XGEN(j)  (2304 + 64 * (j))
#define XB_TOP      3328
#define XB_TOPGEN   3392
#define XCD_BAR_WORDS 3456
#define XB_SPIN_CAP (1u << 18)
DI unsigned xb_ld(unsigned* p) { return __hip_atomic_load(p, __ATOMIC_RELAXED, __HIP_MEMORY_SCOPE_AGENT); }
DI unsigned xb_add(unsigned* p, unsigned v) { return __hip_atomic_fetch_add(p, v, __ATOMIC_RELAXED, __HIP_MEMORY_SCOPE_AGENT); }
DI unsigned xb_xcc_id() { return (unsigned)__builtin_amdgcn_s_getreg((3 << 11) | 20) & 0xFu; }
#define XB_SPIN(cond, bar) do { unsigned _sp = 0; while (cond) { __builtin_amdgcn_s_sleep(1); \
    if ((++_sp & 255u) == 0u) { if (xb_ld(&(bar)[XB_TMO])) break; if (_sp > XB_SPIN_CAP) { atomicAdd(&(bar)[XB_TMO], 1u); break; } } } } while (0)
struct XcdBarrier { unsigned* bar; unsigned x; unsigned nloc, nx; };
DI XcdBarrier xcd_barrier_post(unsigned* bar) {
  XcdBarrier b; b.bar = bar; b.x = xb_xcc_id(); b.nloc = 0u; b.nx = 0u;
  if (threadIdx.x == 0) (void)xb_add(&bar[XB_XCNT(b.x)], 1u);
  return b;
}
DI void xcd_barrier_complete(unsigned* bar, unsigned x, unsigned& nloc, unsigned& nx) {
  const unsigned G = gridDim.x;
  unsigned sum, cnt, mine, sp = 0u;
  for (;;) {
    sum = 0u; cnt = 0u; mine = 0u;
#pragma unroll
    for (unsigned j = 0; j < 16; ++j) { const unsigned c = xb_ld(&bar[XB_XCNT(j)]); sum += c; cnt += (c > 0u) ? 1u : 0u; mine = (j == x) ? c : mine; }
    if (sum == G) break;
    __builtin_amdgcn_s_sleep(1);
    if ((++sp & 255u) == 0u) { if (xb_ld(&bar[XB_TMO])) break; if (sp > XB_SPIN_CAP) { atomicAdd(&bar[XB_TMO], 1u); break; } }
  }
  nloc = mine > 0u ? mine : 1u; nx = cnt > 0u ? cnt : 1u;
}
DI void xcd_barrier(XcdBarrier& b) {
  asm volatile("s_waitcnt vmcnt(0)" ::: "memory");
  if (b.nloc == 0u) {
    unsigned nl, nxx;
    xcd_barrier_complete(b.bar, b.x, nl, nxx);
    b.nloc = __builtin_amdgcn_readfirstlane(nl); b.nx = __builtin_amdgcn_readfirstlane(nxx);
  }
  __syncthreads();
  if (threadIdx.x == 0) {
    unsigned* bar = b.bar;
    __builtin_amdgcn_s_waitcnt(0);
    const unsigned nloc = b.nloc, nx = b.nx;
    const unsigned old = xb_add(&bar[XB_XSUB(b.x)], 1u);
    const unsigned gen = old / nloc;
    if (old + 1u == (gen + 1u) * nloc) {
      __builtin_amdgcn_fence(__ATOMIC_RELEASE, "agent");
      asm volatile("s_waitcnt vmcnt(0)" ::: "memory");
      const unsigned og = xb_add(&bar[XB_TOP], 1u);
      const unsigned tg = og / nx;
      if (og + 1u == (tg + 1u) * nx) xb_add(&bar[XB_TOPGEN], 1u);
      else XB_SPIN(xb_ld(&bar[XB_TOPGEN]) == tg, bar);
      __builtin_amdgcn_fence(__ATOMIC_ACQUIRE, "agent");
      xb_add(&bar[XB_XGEN(b.x)], 1u);
      asm volatile("s_waitcnt vmcnt(0)" ::: "memory");
    } else {
      XB_SPIN(xb_ld(&bar[XB_XGEN(b.x)]) == gen, bar);
      __builtin_amdgcn_fence(__ATOMIC_ACQUIRE, "agent");
      asm volatile("s_waitcnt vmcnt(0)" ::: "memory");
    }
  }
  __syncthreads();
}

__global__ void __launch_bounds__(256, 2) mega(Params p) {
  __shared__ __attribute__((aligned(16))) char lds[65536];
  cg::grid_group grid = cg::this_grid();
  XcdBarrier xb = xcd_barrier_post(p.bar);
#define GRID_SYNC() do { if (p.use_cg) grid.sync(); else xcd_barrier(xb); } while (0)
  phase0(p, lds);
  GRID_SYNC();
  for (int l = 0; l < 4; ++l) {
    phase_inproj(p, l, lds);
#if PROBE_P1
    phase_inproj(p, l, lds);
#endif
    GRID_SYNC();
    phase_attn(p, l, lds);
#if PROBE_B
    if (l == 1) phase_attn(p, l, lds);
#endif
#if PROBE_AC
    if (l != 1) phase_attn(p, l, lds);
#endif
    GRID_SYNC();
    phase_outproj(p, l, lds);
#if PROBE_P3
    if (l == 0) phase_outproj(p, l, lds, true);
#endif
    if (l < 3) GRID_SYNC();
  }
}

extern "C" void kernel_launch(void* const* d_in, const int* in_sizes, int n_in, void* d_out, int out_size, void* d_ws, size_t ws_size, hipStream_t stream) {
  static int grid_blocks = 0;
  if (!grid_blocks) {
    int dev = 0, cus = 0, per_cu = 0;
    (void)hipGetDevice(&dev);
    (void)hipDeviceGetAttribute(&cus, hipDeviceAttributeMultiprocessorCount, dev);
    (void)hipOccupancyMaxActiveBlocksPerMultiprocessor(&per_cu, mega, 256, 0);
    if (per_cu > 2) per_cu = 2;
    grid_blocks = cus * per_cu;
  }
  Params p{};
  p.x = (const float*)d_in[0];
  const int base[4] = {1, 7, 12, 17};
  for (int l = 0; l < 4; ++l) {
    const int b = base[l], hs = (l % 3 == 0) ? 1 : 0;
    p.norm[l] = (const float*)d_in[b]; p.w_in[l] = (const float*)d_in[b + 1]; p.qg[l] = (const float*)d_in[b + 2]; p.kg[l] = (const float*)d_in[b + 3];
    p.sink[l] = hs ? (const float*)d_in[b + 4] : (const float*)d_in[b + 3];
    p.w_out[l] = (const float*)d_in[b + 4 + hs];
  }
  p.out = (float*)d_out;
  char* w = (char*)d_ws; size_t off = 0;
  auto take = [&](size_t bytes) { char* r = w + off; off += (bytes + 255) & ~(size_t)255; return r; };
  p.bar = (unsigned*)take((size_t)XCD_BAR_WORDS * 4); p.use_cg = 0; p.pad0 = 0;
  for (int l = 0; l < 4; ++l) {
    const int kind = l % 3, nin = kind == 2 ? 2816 : 2560, ow = kind == 2 ? 512 : 1024;
    p.wt_in[l] = (bf16_t*)take((size_t)nin * 1024 * 2);
    p.wt_out[l] = (bf16_t*)take((size_t)1024 * ow * 2);
  }
  p.xb = (bf16_t*)take((size_t)S * 1024 * 2);
  p.rs = (float*)take((size_t)4 * S * 4);
  p.Q = (bf16_t*)take((size_t)S * 1536 * 2);
  p.K = (bf16_t*)take((size_t)S * 384 * 2);
  p.Vt = (bf16_t*)take((size_t)6 * 64 * S * 2);
  p.SG = (bf16_t*)take((size_t)S * 1024 * 2);
  p.OG = (bf16_t*)take((size_t)S * 1024 * 2);
  p.rope = (f32x2*)take((size_t)320 * 16 * 8);
  p.wt8 = (unsigned char*)take((size_t)2560 * 1024);
  p.xb8 = (unsigned char*)take((size_t)S * 1024);
  p.wo8 = (unsigned char*)take((size_t)1024 * 1024);
  p.og8 = (unsigned char*)take((size_t)S * 1024);
  (void)hipMemsetAsync(p.bar, 0, (size_t)XCD_BAR_WORDS * 4, stream);
  void* args[] = {&p};
  hipError_t e = hipLaunchCooperativeKernel((void*)mega, dim3(grid_blocks), dim3(256), args, 0, stream);
  if (e != hipSuccess) fprintf(stderr, "coop launch failed: %s (grid %d)\n", hipGetErrorString(e), grid_blocks);
}
```

```cpp
#include <hip/hip_runtime.h>
#include <hip/hip_cooperative_groups.h>
#include <cstdio>
#ifndef PROBE_P3
#define PROBE_P3 0
#endif
#ifndef PROBE_P1
#define PROBE_P1 0
#endif
#ifndef PROBE_B
#define PROBE_B 0
#endif
#ifndef PROBE_AC
#define PROBE_AC 0
#endif
namespace cg = cooperative_groups;

typedef unsigned short bf16_t;
typedef short bf16x8 __attribute__((ext_vector_type(8)));
typedef float f32x16 __attribute__((ext_vector_type(16)));
typedef float f32x4 __attribute__((ext_vector_type(4)));
typedef float f32x2 __attribute__((ext_vector_type(2)));
typedef unsigned u32x4 __attribute__((ext_vector_type(4)));
typedef unsigned u32x2 __attribute__((ext_vector_type(2)));
typedef __bf16 bf2_t __attribute__((ext_vector_type(2)));
#define DI __device__ __forceinline__
#define MFMA32(a, b, c) __builtin_amdgcn_mfma_f32_32x32x16_bf16((a), (b), (c), 0, 0, 0)

constexpr int S = 16384, DM = 1024;
constexpr float EPS = 1e-6f;
constexpr float LOG2E = 1.4426950408889634f;

struct Params {
  const float* x;
  const float* norm[4]; const float* w_in[4]; const float* qg[4]; const float* kg[4]; const float* sink[4]; const float* w_out[4];
  float* out;
  bf16_t* wt_in[4]; bf16_t* wt_out[4];
  bf16_t* xb; float* rs;
  bf16_t* Q; bf16_t* K; bf16_t* Vt; bf16_t* SG; bf16_t* OG;
  f32x2* rope;
  unsigned char* wt8; unsigned char* xb8;
  unsigned* bar; int use_cg; int pad0;
};

DI unsigned pk_bf16(float a, float b) { f32x2 v = {a, b}; bf2_t r = __builtin_convertvector(v, bf2_t); return __builtin_bit_cast(unsigned, r); }
DI int cvt4_fp8(float a, float b, float c, float d) { int w = __builtin_amdgcn_cvt_pk_fp8_f32(a, b, 0, false); return __builtin_amdgcn_cvt_pk_fp8_f32(c, d, w, true); }
DI int cvt4_bf8(float a, float b, float c, float d) { int w; asm volatile("" : "=v"(w)); w = __builtin_amdgcn_cvt_pk_bf8_f32(a, b, w, false); return __builtin_amdgcn_cvt_pk_bf8_f32(c, d, w, true); }
typedef __attribute__((address_space(3))) unsigned lds_u32;
typedef __attribute__((address_space(1))) const unsigned glb_u32;
DI void glds16(const void* g, char* l) { __builtin_amdgcn_global_load_lds((glb_u32*)g, (lds_u32*)l, 16, 0, 0); }
DI float bf_lo(unsigned w) { return __uint_as_float(w << 16); }
DI float bf_hi(unsigned w) { return __uint_as_float(w & 0xffff0000u); }
DI int nin_of(int kind) { return kind == 2 ? 2816 : 2560; }
DI int outw_of(int kind) { return kind == 2 ? 512 : 1024; }
DI int qw_of(int kind) { return kind == 2 ? 1536 : 1024; }
DI int kvw_of(int kind) { return kind == 2 ? 384 : 256; }
DI int lds_off(int row, int c) { return row * 128 + ((c ^ ((row >> 1) & 7)) << 4); }

struct TJob { const float* src; const float* gain; bf16_t* dst; unsigned char* dst8; int N, K, k0, n0; };
DI TJob tj_decode(const Params& p, int job, const int (&cum)[9]) {
  TJob j{};
#pragma unroll
  for (int l = 0; l < 4; ++l) {
    const int kind = l % 3;
    if (job >= cum[2 * l] && job < cum[2 * l + 1]) {
      const int q = job - cum[2 * l];
      j.src = p.w_in[l]; j.gain = p.norm[l]; j.dst = p.wt_in[l]; j.dst8 = l == 1 ? p.wt8 : nullptr; j.N = nin_of(kind); j.K = 1024; j.k0 = (q & 15) * 64; j.n0 = (q >> 4) * 64;
    } else if (job >= cum[2 * l + 1] && job < cum[2 * l + 2]) {
      const int q = job - cum[2 * l + 1], K = outw_of(kind), nkt = K / 64;
      j.src = p.w_out[l]; j.gain = nullptr; j.dst = p.wt_out[l]; j.N = 1024; j.K = K; j.k0 = (q % nkt) * 64; j.n0 = (q / nkt) * 64;
    }
  }
  return j;
}
DI void tj_load(const TJob& j, float (&v)[16], int tid) {
#pragma unroll
  for (int r = 0; r < 16; ++r) {
    const int kk = r * 4 + (tid >> 6), nn = tid & 63;
    v[r] = j.src[(size_t)(j.k0 + kk) * j.N + j.n0 + nn];
    if (j.gain) v[r] *= j.gain[j.k0 + kk];
  }
}
DI void tj_store(const TJob& j, const float (&v)[16], float* tile, int tid) {
#pragma unroll
  for (int r = 0; r < 16; ++r) tile[(r * 4 + (tid >> 6)) * 65 + (tid & 63)] = v[r];
  __syncthreads();
#pragma unroll
  for (int i = 0; i < 2; ++i) {
    const int nn = (tid >> 3) + 32 * i, kc = (tid & 7) * 8;
    u32x4 w;
    w.x = pk_bf16(tile[(kc + 0) * 65 + nn], tile[(kc + 1) * 65 + nn]);
    w.y = pk_bf16(tile[(kc + 2) * 65 + nn], tile[(kc + 3) * 65 + nn]);
    w.z = pk_bf16(tile[(kc + 4) * 65 + nn], tile[(kc + 5) * 65 + nn]);
    w.w = pk_bf16(tile[(kc + 6) * 65 + nn], tile[(kc + 7) * 65 + nn]);
    if (j.dst8) {
      u32x2 w8;
      w8.x = (unsigned)cvt4_fp8(32.f * tile[(kc + 0) * 65 + nn], 32.f * tile[(kc + 1) * 65 + nn], 32.f * tile[(kc + 2) * 65 + nn], 32.f * tile[(kc + 3) * 65 + nn]);
      w8.y = (unsigned)cvt4_fp8(32.f * tile[(kc + 4) * 65 + nn], 32.f * tile[(kc + 5) * 65 + nn], 32.f * tile[(kc + 6) * 65 + nn], 32.f * tile[(kc + 7) * 65 + nn]);
      *(u32x2*)(j.dst8 + (size_t)(j.n0 + nn) * 1024 + j.k0 + kc) = w8;
    } else {
      *(u32x4*)(j.dst + (size_t)(j.n0 + nn) * j.K + j.k0 + kc) = w;
    }
  }
  __syncthreads();
}

DI void phase0(const Params& p, char* lds) {
  int tid_ = threadIdx.x; asm volatile("" : "+v"(tid_));
  const int tid = tid_, G = gridDim.x, lane = tid & 63, wid = tid >> 6;
  float* tile = (float*)lds;
  int cum[9]; cum[0] = 0;
#pragma unroll
  for (int l = 0; l < 4; ++l) { const int kind = l % 3; cum[2 * l + 1] = cum[2 * l] + 16 * (nin_of(kind) / 64); cum[2 * l + 2] = cum[2 * l + 1] + (outw_of(kind) / 64) * 16; }
  const int total = cum[8];
  if ((int)blockIdx.x < total) {
    float va[16], vb[16];
    TJob ja = tj_decode(p, blockIdx.x, cum), jb{};
    tj_load(ja, va, tid);
    for (int job = blockIdx.x; job < total; job += 2 * G) {
      const bool hb = job + G < total, hc = job + 2 * G < total;
      if (hb) { jb = tj_decode(p, job + G, cum); tj_load(jb, vb, tid); }
      tj_store(ja, va, tile, tid);
      if (hc) { ja = tj_decode(p, job + 2 * G, cum); tj_load(ja, va, tid); }
      if (hb) tj_store(jb, vb, tile, tid);
    }
  }
  for (int r0 = blockIdx.x * 4 + wid; r0 < S; r0 += G * 16) {
    f32x4 v[4][4];
#pragma unroll
    for (int q = 0; q < 4; ++q) {
      const int r = r0 + q * G * 4;
      if (r < S) {
#pragma unroll
        for (int i = 0; i < 4; ++i) v[q][i] = *(const f32x4*)(p.x + (size_t)r * DM + i * 256 + lane * 4);
      }
    }
#pragma unroll
    for (int q = 0; q < 4; ++q) {
      const int r = r0 + q * G * 4;
      if (r < S) {
        float ss = 0.f;
#pragma unroll
        for (int i = 0; i < 4; ++i) {
          const f32x4 x4 = v[q][i];
          ss += x4.x * x4.x + x4.y * x4.y + x4.z * x4.z + x4.w * x4.w;
          u32x2 w; w.x = pk_bf16(x4.x, x4.y); w.y = pk_bf16(x4.z, x4.w);
          *(u32x2*)(p.xb + (size_t)r * DM + i * 256 + lane * 4) = w;
        }
#pragma unroll
        for (int o = 32; o >= 1; o >>= 1) ss += __shfl_xor(ss, o);
        if (lane == 0) p.rs[r] = ss;
        else if (lane < 4) p.rs[lane * S + r] = 0.f;
      }
    }
  }
  for (int gt = blockIdx.x * 256 + tid; gt < 320 * 16; gt += G * 256) {
    const int n = gt >> 4, m = gt & 15, nn = n < 256 ? n : n - 256;
    const double b = sqrt(sqrt(10.0));
    double pw = 1.0;
    for (int i = 0; i < m; ++i) pw *= b;
    const float freq = 1.0f / (float)pw;
    const float ang = (float)nn * freq;
    const double a = (double)ang;
    const double kq = rint(a * 0.15915494309189535);
    double r = fma(-kq, 6.283185307179586, a);
    r = fma(-kq, 2.4492935982947064e-16, r);
    const double r2 = r * r;
    double c = 1.0, s = r, tc = 1.0, ts = r;
    for (int q = 1; q <= 14; ++q) {
      tc *= -r2 / (double)((2 * q - 1) * (2 * q)); c += tc;
      ts *= -r2 / (double)((2 * q) * (2 * q + 1)); s += ts;
    }
    f32x2 o; o.x = (float)c; o.y = (float)s;
    p.rope[gt] = o;
  }
}

typedef int v8i __attribute__((ext_vector_type(8)));
#define MFMA8(a, b, c, bfmt) __builtin_amdgcn_mfma_scale_f32_32x32x64_f8f6f4((a), (b), (c), 0, (bfmt), 0, 0, 0, 0)
#define MFMA4(a, b, c) __builtin_amdgcn_mfma_scale_f32_32x32x64_f8f6f4((a), (b), (c), 4, 4, 0, 123, 0, 127)
DI v8i widen4(u32x4 a) { typedef int i4 __attribute__((ext_vector_type(4))); const i4 b = __builtin_bit_cast(i4, a); return __builtin_shufflevector(b, b, 0, 1, 2, 3, -1, -1, -1, -1); }
DI int off8(int row, int c) { return row * 64 + ((c ^ ((row >> 2) & 3)) << 4); }
DI v8i ld32(const char* p0, const char* p1) {
  const u32x4 a = *(const u32x4*)p0, b = *(const u32x4*)p1;
  v8i r; r[0] = a.x; r[1] = a.y; r[2] = a.z; r[3] = a.w; r[4] = b.x; r[5] = b.y; r[6] = b.z; r[7] = b.w; return r;
}

template <bool F8>
DI void gemm_tile(const bf16_t* __restrict__ A, const bf16_t* __restrict__ B, int K, int f0, int t0, char* lds, f32x16 (&acc)[2][2]) {
  int tid_ = threadIdx.x; asm volatile("" : "+v"(tid_));
  const int tid = tid_, lane = tid & 63, wid = tid >> 6, wm = wid >> 1, wn = wid & 1, l32 = lane & 31, h = lane >> 5;
  const int r0 = tid >> 3, c = tid & 7;
#pragma unroll
  for (int i = 0; i < 2; ++i)
#pragma unroll
    for (int j = 0; j < 2; ++j)
#pragma unroll
      for (int r = 0; r < 16; ++r) acc[i][j][r] = 0.f;
  const bf16_t* ag = A + (size_t)(f0 + r0) * K + c * 8;
  const bf16_t* bg = B + (size_t)(t0 + r0) * K + c * 8;
  const int nk = K >> 6;
  u32x4 R0[8], R1[8];
  auto gload = [&](u32x4 (&R)[8], int kt) {
#pragma unroll
    for (int i = 0; i < 4; ++i) { R[i] = *(const u32x4*)(ag + (size_t)(32 * i) * K + kt * 64); R[4 + i] = *(const u32x4*)(bg + (size_t)(32 * i) * K + kt * 64); }
  };
  auto lstore = [&](const u32x4 (&R)[8], int buf) {
    char* d = lds + buf * 32768;
#pragma unroll
    for (int i = 0; i < 4; ++i) { const int off = lds_off(r0 + 32 * i, c); *(u32x4*)(d + off) = R[i]; *(u32x4*)(d + 16384 + off) = R[4 + i]; }
  };
  auto step = [&](int kt, u32x4 (&Ra)[8], const u32x4 (&Rb)[8]) {
    if (kt + 2 < nk) gload(Ra, kt + 2);
    __builtin_amdgcn_sched_barrier(0);
    const char* a = lds + (kt & 1) * 32768;
    const char* b = a + 16384;
    if constexpr (F8) {
#pragma unroll
      for (int ks = 0; ks < 2; ++ks) {
        v8i a8[2], b8[2];
#pragma unroll
        for (int i = 0; i < 2; ++i) {
          a8[i] = ld32(a + lds_off(wm * 64 + i * 32 + l32, 4 * ks + 2 * h), a + lds_off(wm * 64 + i * 32 + l32, 4 * ks + 2 * h + 1));
          b8[i] = ld32(b + lds_off(wn * 64 + i * 32 + l32, 4 * ks + 2 * h), b + lds_off(wn * 64 + i * 32 + l32, 4 * ks + 2 * h + 1));
        }
        __builtin_amdgcn_sched_barrier(0);
#pragma unroll
        for (int i = 0; i < 2; ++i)
#pragma unroll
          for (int j = 0; j < 2; ++j) acc[i][j] = MFMA8(a8[i], b8[j], acc[i][j], 0);
        __builtin_amdgcn_sched_barrier(0);
      }
      if (kt + 1 < nk) lstore(Rb, (kt + 1) & 1);
      __syncthreads();
      return;
    }
    bf16x8 af[2][2], bf[2][2];
#pragma unroll
    for (int i = 0; i < 2; ++i) { af[0][i] = *(const bf16x8*)(a + lds_off(wm * 64 + i * 32 + l32, h)); bf[0][i] = *(const bf16x8*)(b + lds_off(wn * 64 + i * 32 + l32, h)); }
#pragma unroll
    for (int kk = 0; kk < 4; ++kk) {
      if (kk < 3) {
#pragma unroll
        for (int i = 0; i < 2; ++i) { af[(kk + 1) & 1][i] = *(const bf16x8*)(a + lds_off(wm * 64 + i * 32 + l32, 2 * (kk + 1) + h)); bf[(kk + 1) & 1][i] = *(const bf16x8*)(b + lds_off(wn * 64 + i * 32 + l32, 2 * (kk + 1) + h)); }
      }
      __builtin_amdgcn_sched_barrier(0);
#pragma unroll
      for (int i = 0; i < 2; ++i)
#pragma unroll
        for (int j = 0; j < 2; ++j) acc[i][j] = MFMA32(af[kk & 1][i], bf[kk & 1][j], acc[i][j]);
      __builtin_amdgcn_sched_barrier(0);
    }
    if (kt + 1 < nk) lstore(Rb, (kt + 1) & 1);
    __syncthreads();
  };
  gload(R0, 0);
  gload(R1, 1);
  __syncthreads();
  lstore(R0, 0);
  __syncthreads();
#pragma unroll 1
  for (int kt = 0; kt < nk; kt += 2) { step(kt, R0, R1); step(kt + 1, R1, R0); }
}

DI void phase_inproj(const Params& p, int l, char* lds) {
  const int kind = l % 3, NIN = nin_of(kind), NF = NIN / 128, QW = qw_of(kind), KVW = kvw_of(kind), OW = outw_of(kind);
  const int nqh = QW / 64, nkh = KVW / 64;
  int tid_ = threadIdx.x; asm volatile("" : "+v"(tid_));
  const int tid = tid_, lane = tid & 63, wid = tid >> 6, wm = wid >> 1, wn = wid & 1, l32 = lane & 31, h = lane >> 5;
  const float* rs = p.rs + l * S;
  const int ntiles = NF * (S / 128);
  for (int idx = blockIdx.x; idx < ntiles; idx += gridDim.x) {
    const int ti = idx / NF, fi = idx - ti * NF; int f0 = fi * 128, t0 = ti * 128;
    f32x16 acc[2][2];
    if (l == 1) gemm_tile<true>((const bf16_t*)p.wt8, (const bf16_t*)p.xb8, 512, f0, t0, lds, acc);
    else gemm_tile<false>(p.wt_in[l], p.xb, 1024, f0, t0, lds, acc);
    asm volatile("" : "+s"(t0), "+s"(f0));
    const int hb = (f0 >> 6) + wm;
    char* wl = lds + wid * 9216;
#pragma unroll
    for (int j = 0; j < 2; ++j) {
      const int t = t0 + wn * 64 + j * 32 + l32;
      const float rsc = __builtin_amdgcn_rsqf(rs[t] * (1.0f / 1024.0f) + EPS) * (l == 1 ? 0.03125f : 1.0f);
      float v[2][16];
#pragma unroll
      for (int i = 0; i < 2; ++i)
#pragma unroll
        for (int r = 0; r < 16; ++r) v[i][r] = acc[i][j][r] * rsc;
      if (hb < nqh + nkh) {
        const bool isq = hb < nqh;
        const float* gain = isq ? p.qg[l] : p.kg[l];
        float ss = 0.f;
#pragma unroll
        for (int i = 0; i < 2; ++i)
#pragma unroll
          for (int r = 0; r < 16; ++r) ss += v[i][r] * v[i][r];
        ss += __shfl_xor(ss, 32);
        const float nrm = __builtin_amdgcn_rsqf(ss * (1.0f / 64.0f) + EPS) * (isq ? 0.125f * LOG2E : 1.0f);
#pragma unroll
        for (int i = 0; i < 2; ++i)
#pragma unroll
          for (int g = 0; g < 4; ++g) {
            const f32x4 gv = *(const f32x4*)(gain + 32 * i + 8 * g + 4 * h);
            v[i][4 * g + 0] *= nrm * gv.x; v[i][4 * g + 1] *= nrm * gv.y; v[i][4 * g + 2] *= nrm * gv.z; v[i][4 * g + 3] *= nrm * gv.w;
          }
        if (kind == 1) {
#pragma unroll
          for (int i = 0; i < 2; ++i) {
            const f32x2* tab = p.rope + (i == 0 ? (t >> 6) : (256 + (t & 63))) * 16;
#pragma unroll
            for (int g = 0; g < 4; ++g)
#pragma unroll
              for (int e = 0; e < 2; ++e) {
                const f32x2 cs = tab[4 * g + 2 * h + e];
                const float x1 = v[i][4 * g + 2 * e], x2 = v[i][4 * g + 2 * e + 1];
                v[i][4 * g + 2 * e] = x1 * cs.x - x2 * cs.y;
                v[i][4 * g + 2 * e + 1] = x1 * cs.y + x2 * cs.x;
              }
          }
        }
        if (kind == 1) {
          const float mul = isq ? 8.f : 2.f;
          u32x4 w4;
#pragma unroll
          for (int i = 0; i < 2; ++i)
#pragma unroll
            for (int gp = 0; gp < 2; ++gp) {
              unsigned w = 0;
#pragma unroll
              for (int q = 0; q < 8; ++q) {
                const float x = v[i][8 * gp + q] * mul, ax = __builtin_fabsf(x);
                unsigned code = (ax > 0.25f) + (ax > 0.75f) + (ax > 1.25f) + (ax > 1.75f) + (ax > 2.5f) + (ax > 3.5f) + (ax > 5.0f);
                code |= x < 0.f ? 8u : 0u;
                w |= code << (4 * q);
              }
              w4[2 * i + gp] = w;
            }
          unsigned char* qk4 = isq ? (unsigned char*)p.Q + ((size_t)hb * S + t) * 32 : (unsigned char*)p.K + ((size_t)(hb - nqh) * S + t) * 32;
          *(u32x4*)(qk4 + h * 16) = w4;
        } else {
#pragma unroll
          for (int i = 0; i < 2; ++i)
#pragma unroll
            for (int g = 0; g < 4; ++g) {
              u32x2 w; w.x = pk_bf16(v[i][4 * g], v[i][4 * g + 1]); w.y = pk_bf16(v[i][4 * g + 2], v[i][4 * g + 3]);
              *(u32x2*)(wl + (j * 32 + l32) * 144 + (32 * i + 8 * g + 4 * h) * 2) = w;
            }
        }
      } else if (hb < nqh + 2 * nkh) {
        if (kind == 1) {
#pragma unroll
          for (int i = 0; i < 2; ++i)
#pragma unroll
            for (int r = 0; r < 16; ++r) {
              const int d = 32 * i + 8 * (r >> 2) + 4 * h + (r & 3);
              *(unsigned char*)(wl + d * 68 + j * 32 + l32) = (unsigned char)(__builtin_amdgcn_cvt_pk_fp8_f32(v[i][r], v[i][r], 0, false) & 0xff);
            }
        } else
#pragma unroll
        for (int i = 0; i < 2; ++i)
#pragma unroll
          for (int r = 0; r < 16; r += 2) {
            const unsigned w = pk_bf16(v[i][r], v[i][r + 1]);
            const int d = 32 * i + 8 * (r >> 2) + 4 * h + (r & 3);
            *(bf16_t*)(wl + d * 132 + (j * 32 + l32) * 2) = (bf16_t)(w & 0xffff);
            *(bf16_t*)(wl + (d + 1) * 132 + (j * 32 + l32) * 2) = (bf16_t)(w >> 16);
          }
      } else {
#pragma unroll
        for (int i = 0; i < 2; ++i)
#pragma unroll
          for (int g = 0; g < 4; ++g) {
            float s4[4];
#pragma unroll
            for (int e = 0; e < 4; ++e) { const float u = v[i][4 * g + e]; s4[e] = u * __builtin_amdgcn_rcpf(1.0f + __builtin_amdgcn_exp2f(-u * LOG2E)); }
            u32x2 w; w.x = pk_bf16(s4[0], s4[1]); w.y = pk_bf16(s4[2], s4[3]);
            *(u32x2*)(wl + (j * 32 + l32) * 144 + (32 * i + 8 * g + 4 * h) * 2) = w;
          }
      }
    }
    const int tb = t0 + wn * 64;
    if (kind == 1 && hb < nqh + 2 * nkh) {
      if (hb < nqh + nkh) {
      } else {
        unsigned char* vbase = (unsigned char*)p.Vt + ((size_t)(hb - nqh - nkh) * 256 + (tb >> 6)) * 4096;
#pragma unroll
        for (int ps = 0; ps < 4; ++ps) {
          const int id = ps * 64 + lane, d = id >> 2, cq = id & 3, hh = cq >> 1, mq = cq & 1;
          const char* src = wl + d * 68 + 32 * mq + 4 * hh;
          u32x4 val; val.x = *(const unsigned*)(src); val.y = *(const unsigned*)(src + 8); val.z = *(const unsigned*)(src + 16); val.w = *(const unsigned*)(src + 24);
          *(u32x4*)(vbase + d * 64 + 16 * cq) = val;
        }
      }
    } else if (hb >= nqh + nkh && hb < nqh + 2 * nkh) {
      const int slot = hb - nqh - nkh;
      const int dsh = kind == 2 ? 2 * (slot >> 1) : 0, dil = 1 << dsh;
      bf16_t* vbase = p.Vt + (size_t)slot * 64 * S;
#pragma unroll 4
      for (int ps = 0; ps < 16; ++ps) {
        const int u = ps * 64 + lane, d = u >> 4, m = u & 15, c = m & (dil - 1), kq = m >> dsh;
        const char* src = wl + d * 132 + (c + dil * 4 * kq) * 2;
        const unsigned a0 = *(const bf16_t*)(src), a1 = *(const bf16_t*)(src + dil * 2), a2 = *(const bf16_t*)(src + dil * 4), a3 = *(const bf16_t*)(src + dil * 6);
        u32x2 w; w.x = a0 | (a1 << 16); w.y = a2 | (a3 << 16);
        const int pi = (c << (14 - dsh)) + (tb >> dsh) + 4 * kq;
        const int lo = pi & 15, pos = (pi & ~15) | (lo & 3) | (((lo >> 2) & 1) << 3) | (((lo >> 3) & 1) << 2);
        *(u32x2*)(vbase + (size_t)(pos >> 6) * 4096 + d * 64 + (pos & 63)) = w;
      }
    } else {
      bf16_t* dbase; size_t pitch;
      if (hb < nqh) { dbase = p.Q + (size_t)tb * QW + hb * 64; pitch = QW; }
      else if (hb < nqh + nkh) { dbase = p.K + ((size_t)(hb - nqh) * S + tb) * 64; pitch = 64; }
      else { dbase = p.SG + (size_t)tb * OW + (hb - nqh - 2 * nkh) * 64; pitch = OW; }
#pragma unroll
      for (int ps = 0; ps < 8; ++ps) {
        const int row = ps * 8 + (lane >> 3), ch = lane & 7;
        const u32x4 val = *(const u32x4*)(wl + row * 144 + ch * 16);
        *(u32x4*)(dbase + (size_t)row * pitch + ch * 8) = val;
      }
    }
  }
}

DI void phase_outproj(const Params& p, int l, char* lds, bool dry = false) {
  const int kind = l % 3, OW = outw_of(kind);
  int tid_ = threadIdx.x; asm volatile("" : "+v"(tid_));
  const int tid = tid_, lane = tid & 63, wid = tid >> 6, wm = wid >> 1, wn = wid & 1, l32 = lane & 31, h = lane >> 5;
  const float* xres = l == 0 ? p.x : p.out;
  float* rsn = p.rs + (l + 1) * S;
  const int ntiles = 8 * (S / 128);
  for (int idx = blockIdx.x; idx < ntiles; idx += gridDim.x) {
    const int ti = idx >> 3, fi = idx & 7; int f0 = fi * 128, t0 = ti * 128;
    f32x16 acc[2][2];
    gemm_tile<false>(p.wt_out[l], p.OG, OW, f0, t0, lds, acc);
    asm volatile("" : "+s"(t0), "+s"(f0));
    char* wl = lds + wid * 8704;
#pragma unroll
    for (int j = 0; j < 2; ++j) {
#pragma unroll
      for (int i = 0; i < 2; ++i)
#pragma unroll
        for (int g = 0; g < 4; ++g) {
          f32x4 a; a.x = acc[i][j][4 * g]; a.y = acc[i][j][4 * g + 1]; a.z = acc[i][j][4 * g + 2]; a.w = acc[i][j][4 * g + 3];
          *(f32x4*)(wl + l32 * 272 + (32 * i + 8 * g + 4 * h) * 4) = a;
        }
#pragma unroll
      for (int ps = 0; ps < 8; ++ps) {
        const int row = ps * 4 + (lane >> 4), ch = lane & 15;
        const f32x4 a = *(const f32x4*)(wl + row * 272 + ch * 16);
        const int t = t0 + wn * 64 + j * 32 + row;
        const size_t o = (size_t)t * DM + f0 + wm * 64 + ch * 4;
        f32x4 xv = *(const f32x4*)(xres + o);
        xv.x += a.x; xv.y += a.y; xv.z += a.z; xv.w += a.w;
        *(f32x4*)(p.out + o) = xv;
        if (l < 3) {
          if (l == 0) { *(int*)(p.xb8 + o) = cvt4_fp8(xv.x, xv.y, xv.z, xv.w); }
          else { u32x2 w; w.x = pk_bf16(xv.x, xv.y); w.y = pk_bf16(xv.z, xv.w); *(u32x2*)(p.xb + o) = w; }
          float ss = xv.x * xv.x + xv.y * xv.y + xv.z * xv.z + xv.w * xv.w;
          ss += __shfl_xor(ss, 1); ss += __shfl_xor(ss, 2); ss += __shfl_xor(ss, 4); ss += __shfl_xor(ss, 8);
          if (ch == 0 && !dry) atomicAdd(rsn + t, ss);
        }
      }
    }
  }
}

template <bool MASKED>
DI void attn_group(const bf16_t* __restrict__ Qp, int qld, const bf16_t* __restrict__ Kp, int kld, const bf16_t* __restrict__ Vtp,
                   int T0, int qs, int dsh, int W, float slope_c, float sc, float Mc, f32x16 (&oacc)[2], float& lsum, char* lds) {
  int tid_ = threadIdx.x; asm volatile("" : "+v"(tid_));
  const int tid = tid_, lane = tid & 63, wid = tid >> 6, l32 = lane & 31, h = lane >> 5;
  const int dil = 1 << dsh, L = S >> dsh, c_d = T0 & (dil - 1), U0 = T0 >> dsh;
  const int tq = T0 + qs * (wid * 32 + l32);
  const int tq_lo = T0 + qs * (wid * 32), tq_hi = tq_lo + qs * 31;
  bf16x8 qf[4];
#pragma unroll
  for (int kk = 0; kk < 4; ++kk) qf[kk] = *(const bf16x8*)(Qp + (size_t)tq * qld + 16 * kk + 8 * h);
  int Ub = 0, Ue = S;
  if (MASKED) {
    const int Wd = W >> dsh, lo = U0 - Wd, hi = U0 + (qs >> dsh) * 127 + Wd + 1;
    Ub = lo < 0 ? 0 : (lo & ~63);
    Ue = hi < L ? hi : L;
  }
  const int ntiles = (Ue - Ub + 63) >> 6;
  const int r0 = tid >> 3, c = tid & 7;
  const bf16_t* kg = Kp + (size_t)(c_d + dil * (Ub + r0)) * kld + c * 8;
  const size_t kstep32 = (size_t)(dil * 32) * kld, kstep64 = (size_t)(dil * 64) * kld;
  const bf16_t* vg = Vtp + (size_t)((c_d * L + Ub) >> 6) * 4096 + r0 * 64 + c * 8;
  u32x4 R0[4], R1[4];
  auto gload = [&](u32x4 (&R)[4], int t) {
#pragma unroll
    for (int i = 0; i < 2; ++i) { R[i] = *(const u32x4*)(kg + t * kstep64 + i * kstep32); R[2 + i] = *(const u32x4*)(vg + 2048 * i + (size_t)t * 4096); }
  };
  auto lstore = [&](const u32x4 (&R)[4], int buf) {
    char* d = lds + buf * 16384;
#pragma unroll
    for (int i = 0; i < 2; ++i) { const int off = lds_off(r0 + 32 * i, c); *(u32x4*)(d + off) = R[i]; *(u32x4*)(d + 8192 + off) = R[2 + i]; }
  };
  auto step = [&](int t, u32x4 (&Ra)[4], const u32x4 (&Rb)[4]) {
    if (t + 2 < ntiles) gload(Ra, t + 2);
    __builtin_amdgcn_sched_barrier(0);
    const int tile_tok0 = c_d + dil * (Ub + 64 * t);
    bool active = true;
    if (MASKED) active = !(tile_tok0 > tq_hi + W || tile_tok0 + dil * 63 < tq_lo - W);
    if (active) {
      const char* kb = lds + (t & 1) * 16384;
      const char* vb = kb + 8192;
      f32x16 sacc[2];
#pragma unroll
      for (int kt = 0; kt < 2; ++kt)
#pragma unroll
        for (int r = 0; r < 16; ++r) sacc[kt][r] = -Mc;
      bf16x8 kf[2][4];
#pragma unroll
      for (int kk = 0; kk < 4; ++kk)
#pragma unroll
        for (int kt = 0; kt < 2; ++kt) kf[kt][kk] = *(const bf16x8*)(kb + lds_off(32 * kt + l32, 2 * kk + h));
      __builtin_amdgcn_sched_barrier(0);
#pragma unroll
      for (int kk = 0; kk < 4; ++kk)
#pragma unroll
        for (int kt = 0; kt < 2; ++kt) sacc[kt] = MFMA32(kf[kt][kk], qf[kk], sacc[kt]);
      bf16x8 vf[4][2];
#pragma unroll
      for (int s = 0; s < 4; ++s)
#pragma unroll
        for (int i = 0; i < 2; ++i) vf[s][i] = *(const bf16x8*)(vb + lds_off(32 * i + l32, 2 * s + h));
      __builtin_amdgcn_sched_barrier(0);
      if (MASKED) {
        const float Wf = (float)W, ndil = -(float)dil;
        const float nd1 = __uint_as_float(__builtin_amdgcn_readfirstlane(__float_as_uint(ndil)));
        const float nd2 = __uint_as_float(__builtin_amdgcn_readfirstlane(__float_as_uint(2.f * ndil)));
        const float nd3 = __uint_as_float(__builtin_amdgcn_readfirstlane(__float_as_uint(3.f * ndil)));
        const float nd8 = __uint_as_float(__builtin_amdgcn_readfirstlane(__float_as_uint(8.f * ndil)));
        float dg = (float)(tq - tile_tok0 - dil * 4 * h);
#pragma unroll
        for (int kt = 0; kt < 2; ++kt)
#pragma unroll
          for (int g = 0; g < 4; ++g) {
            const float d4[4] = {dg, dg + nd1, dg + nd2, dg + nd3};
#pragma unroll
            for (int e = 0; e < 4; ++e) {
              const float ex = __builtin_amdgcn_exp2f(__builtin_fmaf(-slope_c, __builtin_fabsf(d4[e]), sacc[kt][4 * g + e]));
              const float pv = __builtin_fabsf(d4[e]) <= Wf ? ex : 0.f;
              lsum += pv;
              sacc[kt][4 * g + e] = pv;
            }
            dg += nd8;
          }
      } else {
#pragma unroll
        for (int kt = 0; kt < 2; ++kt)
#pragma unroll
          for (int r = 0; r < 16; ++r) { const float pv = __builtin_amdgcn_exp2f(sacc[kt][r]); lsum += pv; sacc[kt][r] = pv; }
      }
#pragma unroll
      for (int s = 0; s < 4; ++s) {
        u32x4 pw;
        const int kt = s >> 1, b = 8 * (s & 1);
        pw.x = pk_bf16(sacc[kt][b + 0], sacc[kt][b + 1]); pw.y = pk_bf16(sacc[kt][b + 2], sacc[kt][b + 3]);
        pw.z = pk_bf16(sacc[kt][b + 4], sacc[kt][b + 5]); pw.w = pk_bf16(sacc[kt][b + 6], sacc[kt][b + 7]);
        const bf16x8 pf = __builtin_bit_cast(bf16x8, pw);
#pragma unroll
        for (int i = 0; i < 2; ++i) oacc[i] = MFMA32(vf[s][i], pf, oacc[i]);
      }
    }
    __builtin_amdgcn_sched_barrier(0);
    if (t + 1 < ntiles) lstore(Rb, (t + 1) & 1);
    __syncthreads();
  };
  gload(R0, 0);
  if (ntiles > 1) gload(R1, 1);
  lstore(R0, 0);
  __syncthreads();
#pragma unroll 1
  for (int t = 0; t < ntiles; t += 2) { step(t, R0, R1); if (t + 1 < ntiles) step(t + 1, R1, R0); }
}


DI void attn_dense_fast(const bf16_t* __restrict__ Qp, const bf16_t* __restrict__ Kp, const bf16_t* __restrict__ Vtp, int T0,
                        f32x16 (&oacc)[2], float& lsum, char* lds) {
  int tid_ = threadIdx.x; asm volatile("" : "+v"(tid_));
  const int tid = tid_, lane = tid & 63, wid = tid >> 6, l32 = lane & 31, h = lane >> 5;
  const int tq = T0 + wid * 32 + l32;
  bf16x8 qf[4];
#pragma unroll
  for (int kk = 0; kk < 4; ++kk) qf[kk] = *(const bf16x8*)(Qp + (size_t)tq * 1024 + 16 * kk + 8 * h);
  const int r0 = tid >> 3, c = tid & 7;
  const bf16_t* kg = Kp + (size_t)r0 * 64 + c * 8;
  const bf16_t* vg = Vtp + r0 * 64 + c * 8;
  constexpr int n = S / 64;
  u32x4 R0[4], R1[4];
  auto gload = [&](u32x4 (&R)[4], int t) {
#pragma unroll
    for (int i = 0; i < 2; ++i) { R[i] = *(const u32x4*)(kg + (size_t)(t * 64 + 32 * i) * 64); R[2 + i] = *(const u32x4*)(vg + 2048 * i + (size_t)t * 4096); }
  };
  auto lstore = [&](const u32x4 (&R)[4], int buf) {
    char* d = lds + buf * 16384;
#pragma unroll
    for (int i = 0; i < 2; ++i) { const int off = lds_off(r0 + 32 * i, c); *(u32x4*)(d + off) = R[i]; *(u32x4*)(d + 8192 + off) = R[2 + i]; }
  };
  int koff[4], voff[2][2];
#pragma unroll
  for (int kk = 0; kk < 4; ++kk) koff[kk] = lds_off(l32, 2 * kk + h);
  f32x16 SA, SB;
  float ls0 = 0.f, ls1 = 0.f;
  bf16x8 kf[4];
  bf16x8 vf[2][2];
  bf16x8 pf[2];
#define FENCE() __builtin_amdgcn_sched_barrier(0)
#define EX(i) pv[i] = __builtin_amdgcn_exp2f(Sc[i])
  auto half = [&](const f32x16& Sc, f32x16& Sn, const char* knext, const char* vcur, int hv) {
    f32x16 z;
#pragma unroll
    for (int r = 0; r < 16; ++r) z[r] = 0.f;
    float pv[16];
    u32x4 pw0, pw1;
    const int vo00 = lds_off(l32, 2 * (2 * hv) + h), vo01 = lds_off(32 + l32, 2 * (2 * hv) + h);
    const int vo10 = lds_off(l32, 2 * (2 * hv + 1) + h), vo11 = lds_off(32 + l32, 2 * (2 * hv + 1) + h);
    FENCE();
    Sn = MFMA32(kf[0], qf[0], z);               kf[0] = *(const bf16x8*)(knext + koff[0]);  EX(0); EX(1); EX(2);      FENCE();
    oacc[0] = MFMA32(vf[0][0], pf[0], oacc[0]); vf[0][0] = *(const bf16x8*)(vcur + vo00);   EX(3); EX(4); EX(5);      FENCE();
    Sn = MFMA32(kf[1], qf[1], Sn);              kf[1] = *(const bf16x8*)(knext + koff[1]);  EX(6); EX(7); EX(8);      FENCE();
    oacc[1] = MFMA32(vf[0][1], pf[0], oacc[1]); vf[0][1] = *(const bf16x8*)(vcur + vo01);   EX(9); EX(10); EX(11);    FENCE();
    Sn = MFMA32(kf[2], qf[2], Sn);              kf[2] = *(const bf16x8*)(knext + koff[2]);  EX(12); EX(13); EX(14); EX(15); FENCE();
    oacc[0] = MFMA32(vf[1][0], pf[1], oacc[0]); vf[1][0] = *(const bf16x8*)(vcur + vo10);
    pw0.x = pk_bf16(pv[0], pv[1]); pw0.y = pk_bf16(pv[2], pv[3]); pw0.z = pk_bf16(pv[4], pv[5]); pw0.w = pk_bf16(pv[6], pv[7]);
    ls0 += pv[0]; ls1 += pv[1];                                                                                        FENCE();
    Sn = MFMA32(kf[3], qf[3], Sn);              kf[3] = *(const bf16x8*)(knext + koff[3]);
    pw1.x = pk_bf16(pv[8], pv[9]); pw1.y = pk_bf16(pv[10], pv[11]); pw1.z = pk_bf16(pv[12], pv[13]); pw1.w = pk_bf16(pv[14], pv[15]);
    ls0 += pv[2]; ls1 += pv[3];                                                                                        FENCE();
    oacc[1] = MFMA32(vf[1][1], pf[1], oacc[1]); vf[1][1] = *(const bf16x8*)(vcur + vo11);
    ls0 += pv[4]; ls1 += pv[5]; ls0 += pv[6]; ls1 += pv[7]; ls0 += pv[8]; ls1 += pv[9]; ls0 += pv[10]; ls1 += pv[11]; ls0 += pv[12]; ls1 += pv[13]; ls0 += pv[14]; ls1 += pv[15];
    asm volatile("" : "+v"(ls0), "+v"(ls1));
    FENCE();
    pf[0] = __builtin_bit_cast(bf16x8, pw0); pf[1] = __builtin_bit_cast(bf16x8, pw1);
  };
  gload(R0, 0);
  gload(R1, 1);
  lstore(R0, 0);
  lstore(R1, 1);
  gload(R0, 2);
  __syncthreads();
  {
    f32x16 z;
#pragma unroll
    for (int r = 0; r < 16; ++r) z[r] = 0.f;
    SA = z;
#pragma unroll
    for (int kk = 0; kk < 4; ++kk) SA = MFMA32(*(const bf16x8*)(lds + koff[kk]), qf[kk], SA);
#pragma unroll
    for (int kk = 0; kk < 4; ++kk) kf[kk] = *(const bf16x8*)(lds + 4096 + koff[kk]);
    const u32x4 zz = {0u, 0u, 0u, 0u};
    pf[0] = __builtin_bit_cast(bf16x8, zz); pf[1] = pf[0];
#pragma unroll
    for (int s = 0; s < 2; ++s)
#pragma unroll
      for (int i = 0; i < 2; ++i) vf[s][i] = *(const bf16x8*)(lds + 8192 + lds_off(32 * i + l32, 2 * s + h));
  }
  int bcur = 0;
  auto tile = [&](int t, u32x4 (&Rload)[4], const u32x4 (&Rstore)[4]) {
    if (t + 3 < n) gload(Rload, t + 3);
    FENCE();
    const int bnext = bcur == 2 ? 0 : bcur + 1, bwr = bnext == 2 ? 0 : bnext + 1;
    const char* cur = lds + bcur * 16384;
    const char* nxt = lds + bnext * 16384;
    half(SA, SB, nxt, cur + 8192, 0);
    half(SB, SA, nxt + 4096, cur + 8192, 1);
    if (t + 2 < n) lstore(Rstore, bwr);
    bcur = bnext;
    __syncthreads();
  };
#pragma unroll 1
  for (int t = 0; t < n; t += 2) { tile(t, R1, R0); tile(t + 1, R0, R1); }
#pragma unroll
  for (int s = 0; s < 2; ++s)
#pragma unroll
    for (int i = 0; i < 2; ++i) oacc[i] = MFMA32(vf[s][i], pf[s], oacc[i]);
  lsum += ls0 + ls1;
}


template <bool SHIFTED>
DI void attn_dense_fp8(const unsigned char* __restrict__ Qp, const unsigned char* __restrict__ Kp, const unsigned char* __restrict__ Vp, int T0, float shift,
                       f32x16 (&oacc)[2], float& lsum, char* lds) {
  int tid_ = threadIdx.x; asm volatile("" : "+v"(tid_));
  const int tid = tid_, lane = tid & 63, wid = tid >> 6, l32 = lane & 31, h = lane >> 5;
  const int tq = T0 + wid * 32 + l32;
  const v8i qf = widen4(*(const u32x4*)(Qp + (size_t)tq * 32 + h * 16));
  const int lr = tid >> 2, lc = (tid & 3) ^ ((lr >> 2) & 3);
  const unsigned goff = (unsigned)(lr * 64 + lc * 16);
#define kg (Kp + goff)
#define vg (Vp + goff)
  constexpr int n = S / 64;
  const int kP = (wid & 1) * 64 + lane, krow = kP >> 1, kc = (kP & 1) ^ ((krow >> 3) & 1);
  const unsigned koff4 = (unsigned)(krow * 32 + kc * 16);
  int fo4[2];
#pragma unroll
  for (int x = 0; x < 2; ++x) fo4[x] = (32 * x + l32) * 32 + ((h ^ ((l32 >> 3) & 1)) << 4);
  int fo[2][2];
#pragma unroll
  for (int x = 0; x < 2; ++x) { fo[x][0] = off8(32 * x + l32, 2 * h); fo[x][1] = off8(32 * x + l32, 2 * h + 1); }
  f32x16 zs;
#pragma unroll
  for (int r = 0; r < 16; ++r) zs[r] = 0.f;
  f32x16 SA[2], SB[2];
  v8i kf[2], vf[2], pf;
  float ls0 = 0.f, ls1 = 0.f;
#define FENCE() __builtin_amdgcn_sched_barrier(0)
#define EXA(i) pa[i] = __builtin_amdgcn_exp2f(SHIFTED ? Sc[0][i] - shift : Sc[0][i])
#define EXB(i) pb[i] = __builtin_amdgcn_exp2f(SHIFTED ? Sc[1][i] - shift : Sc[1][i])
  auto tile = [&](const f32x16 (&Sc)[2], f32x16 (&Sn)[2], const char* k2, const char* v0) {
    float pa[16], pb[16];
    FENCE();
    Sn[0] = MFMA4(kf[0], qf, zs);
    EXA(0); EXA(1); EXA(2); EXA(3); EXA(4); EXA(5); EXA(6); EXA(7); EXA(8); EXA(9); EXA(10);                     FENCE();
    oacc[0] = MFMA8(vf[0], pf, oacc[0], 1);     kf[0] = widen4(*(const u32x4*)(k2 + fo4[0]));
    EXA(11); EXA(12); EXA(13); EXA(14); EXA(15); EXB(0); EXB(1); EXB(2); EXB(3); EXB(4); EXB(5);
    v8i pn;
#pragma unroll
    for (int w = 0; w < 4; ++w) pn[w] = cvt4_bf8(pa[4 * w], pa[4 * w + 1], pa[4 * w + 2], pa[4 * w + 3]);
#pragma unroll
    for (int r = 0; r < 16; r += 2) { ls0 += pa[r]; ls1 += pa[r + 1]; }
    asm volatile("" : "+v"(ls0), "+v"(ls1));                                                                    FENCE();
    Sn[1] = MFMA4(kf[1], qf, zs);               vf[0] = ld32(v0 + fo[0][0], v0 + fo[0][1]);
    EXB(6); EXB(7); EXB(8); EXB(9); EXB(10); EXB(11); EXB(12); EXB(13); EXB(14); EXB(15);                         FENCE();
    oacc[1] = MFMA8(vf[1], pf, oacc[1], 1);     kf[1] = widen4(*(const u32x4*)(k2 + fo4[1]));
    FENCE();
    vf[1] = ld32(v0 + fo[1][0], v0 + fo[1][1]);
#pragma unroll
    for (int w = 0; w < 4; ++w) pn[4 + w] = cvt4_bf8(pb[4 * w], pb[4 * w + 1], pb[4 * w + 2], pb[4 * w + 3]);
#pragma unroll
    for (int r = 0; r < 16; r += 2) { ls0 += pb[r]; ls1 += pb[r + 1]; }
    asm volatile("" : "+v"(ls0), "+v"(ls1));
    FENCE();
    pf = pn;
  };
  auto tbase = [&](int k) { return ((k >> 1) & 3) * 16384 + (k & 1) * 8192; };
  const int wsel = __builtin_amdgcn_readfirstlane(wid >> 1);
  auto dmav = [&](int k) { glds16(Vp + (size_t)k * 4096 + goff, lds + tbase(k) + 4096 + tid * 16); };
  auto dmak = [&](int kpair) { const int k = kpair + wsel; glds16(Kp + (size_t)k * 2048 + koff4, lds + tbase(k) + kP * 16); };
  dmav(0); dmav(1); dmav(2); dmav(3); dmav(4); dmav(5);
  dmak(0); dmak(2); dmak(4);
  asm volatile("s_waitcnt vmcnt(0)" ::: "memory");
  __builtin_amdgcn_s_barrier();
  {
    kf[0] = widen4(*(const u32x4*)(lds + fo4[0])); kf[1] = widen4(*(const u32x4*)(lds + fo4[1]));
    SA[0] = MFMA4(kf[0], qf, zs); SA[1] = MFMA4(kf[1], qf, zs);
    kf[0] = widen4(*(const u32x4*)(lds + 8192 + fo4[0])); kf[1] = widen4(*(const u32x4*)(lds + 8192 + fo4[1]));
    vf[0] = ld32(lds + 4096 + fo[0][0], lds + 4096 + fo[0][1]); vf[1] = ld32(lds + 4096 + fo[1][0], lds + 4096 + fo[1][1]);
#pragma unroll
    for (int w = 0; w < 8; ++w) pf[w] = 0;
  }
#pragma unroll 1
  for (int t8 = 0; t8 < n; t8 += 8) {
#pragma unroll
    for (int u = 0; u < 4; ++u) {
      const int t = t8 + 2 * u;
      const bool more = t + 6 < n;
      if (more) {
        char* d = lds + ((u + 3) & 3) * 16384;
        glds16(Vp + (size_t)(t + 6) * 4096 + goff, d + 4096 + tid * 16);
        glds16(Vp + (size_t)(t + 7) * 4096 + goff, d + 8192 + 4096 + tid * 16);
        glds16(Kp + (size_t)(t + 6 + wsel) * 2048 + koff4, d + wsel * 8192 + kP * 16);
      }
      tile(SA, SB, lds + ((u + 1) & 3) * 16384, lds + u * 16384 + 4096);
      tile(SB, SA, lds + ((u + 1) & 3) * 16384 + 8192, lds + u * 16384 + 8192 + 4096);
      if (more) asm volatile("s_waitcnt vmcnt(3) lgkmcnt(0)" ::: "memory");
      else asm volatile("s_waitcnt vmcnt(0) lgkmcnt(0)" ::: "memory");
      __builtin_amdgcn_s_barrier();
    }
  }
  oacc[0] = MFMA8(vf[0], pf, oacc[0], 1);
  oacc[1] = MFMA8(vf[1], pf, oacc[1], 1);
  lsum += ls0 + ls1;
#undef EXA
#undef EXB
#undef kg
#undef vg
}

DI float gain_bound(const float* qg, const float* kg) {
  float a = 0.f, b = 0.f;
  for (int i = 0; i < 64; ++i) { a = fmaxf(a, fabsf(qg[i])); b = fmaxf(b, fabsf(kg[i])); }
  return 8.0f * a * b;
}

DI void attn_store(const Params& p, const f32x16 (&oacc)[2], float ltot, int t, int OW, int ocol) {
  const int h = (threadIdx.x & 63) >> 5;
  const float inv = 1.0f / ltot;
#pragma unroll
  for (int i = 0; i < 2; ++i)
#pragma unroll
    for (int g = 0; g < 4; ++g) {
      const size_t o = (size_t)t * OW + ocol + 32 * i + 8 * g + 4 * h;
      const u32x2 sg = *(const u32x2*)(p.SG + o);
      u32x2 w;
      w.x = pk_bf16(oacc[i][4 * g] * inv * bf_lo(sg.x), oacc[i][4 * g + 1] * inv * bf_hi(sg.x));
      w.y = pk_bf16(oacc[i][4 * g + 2] * inv * bf_lo(sg.y), oacc[i][4 * g + 3] * inv * bf_hi(sg.y));
      *(u32x2*)(p.OG + o) = w;
    }
}

DI void phase_attn(const Params& p, int l, char* lds) {
  const int kind = l % 3;
  const int tid = threadIdx.x, lane = tid & 63, wid = tid >> 6, l32 = lane & 31;
  const float bound = gain_bound(p.qg[l], p.kg[l]);
  const float sc = 0.125f * LOG2E;
  if (kind == 0) {
    for (int idx = blockIdx.x; idx < 16 * 128; idx += gridDim.x) {
      const int head = idx & 15, qt = idx >> 4, T0 = qt * 128;
      const float sk = p.sink[l][head], M = fmaxf(bound, sk);
      const float slope = exp2f(-0.5f * (float)(head + 1));
      f32x16 oacc[2]; float lsum = 0.f;
#pragma unroll
      for (int i = 0; i < 2; ++i)
#pragma unroll
        for (int r = 0; r < 16; ++r) oacc[i][r] = 0.f;
      attn_group<true>(p.Q + head * 64, 1024, p.K + (size_t)(head >> 2) * S * 64, 64, p.Vt + (size_t)(head >> 2) * 64 * S, T0, 1, 0, 128, slope * LOG2E, sc, M * LOG2E, oacc, lsum, lds);
      float ltot = lsum + __shfl_xor(lsum, 32);
      ltot += __builtin_amdgcn_exp2f((sk - M) * LOG2E);
      attn_store(p, oacc, ltot, T0 + wid * 32 + l32, 1024, head * 64);
    }
  } else if (kind == 1) {
    for (int idx = blockIdx.x; idx < 16 * 128; idx += gridDim.x) {
      const int kvh = (idx & 7) >> 1, rest = ((idx >> 3) << 1) | (idx & 1), head = kvh * 4 + (rest & 3), qt = rest >> 2, T0 = qt * 128;
      f32x16 oacc[2]; float lsum = 0.f;
#pragma unroll
      for (int i = 0; i < 2; ++i)
#pragma unroll
        for (int r = 0; r < 16; ++r) oacc[i][r] = 0.f;
      const float Mc = bound * LOG2E;
      if (Mc > 14.f) attn_dense_fp8<true>((const unsigned char*)p.Q + (size_t)head * S * 32, (const unsigned char*)p.K + (size_t)kvh * S * 32, (const unsigned char*)p.Vt + (size_t)kvh * 64 * S, T0, Mc - 14.f, oacc, lsum, lds);
      else attn_dense_fp8<false>((const unsigned char*)p.Q + (size_t)head * S * 32, (const unsigned char*)p.K + (size_t)kvh * S * 32, (const unsigned char*)p.Vt + (size_t)kvh * 64 * S, T0, 0.f, oacc, lsum, lds);
      const float ltot = lsum + __shfl_xor(lsum, 32);
      attn_store(p, oacc, ltot, T0 + wid * 32 + l32, 1024, head * 64);
    }
  } else {
    for (int idx = blockIdx.x; idx < 8 * 128; idx += gridDim.x) {
      const int slot = idx & 7, set = idx >> 3, T0 = (set >> 4) * 2048 + (set & 15);
      f32x16 oacc[2]; float lsum = 0.f;
#pragma unroll
      for (int i = 0; i < 2; ++i)
#pragma unroll
        for (int r = 0; r < 16; ++r) oacc[i][r] = 0.f;
      for (int gi = 0; gi < 3; ++gi) {
        const int head = gi * 8 + slot, kvs = gi * 2 + (slot >> 2), dsh = 2 * gi, W = 64 << dsh;
        const float slope = exp2f(-8.0f * (float)(head + 1) / 24.0f);
        attn_group<true>(p.Q + head * 64, 1536, p.K + (size_t)kvs * S * 64, 64, p.Vt + (size_t)kvs * 64 * S, T0, 16, dsh, W, slope * LOG2E, sc, bound * LOG2E, oacc, lsum, lds);
      }
      const float ltot = lsum + __shfl_xor(lsum, 32);
      attn_store(p, oacc, ltot, T0 + 16 * (wid * 32 + l32), 512, slot * 64);
    }
  }
}


#define XB_TMO      128
#define XB_XCNT(j)  (256  + 64 * (j))
#define XB_XSUB(j)  (1280 + 64 * (j))
#define XB_XGEN(j)  (2304 + 64 * (j))
#define XB_TOP      3328
#define XB_TOPGEN   3392
#define XCD_BAR_WORDS 3456
#define XB_SPIN_CAP (1u << 18)
DI unsigned xb_ld(unsigned* p) { return __hip_atomic_load(p, __ATOMIC_RELAXED, __HIP_MEMORY_SCOPE_AGENT); }
DI unsigned xb_add(unsigned* p, unsigned v) { return __hip_atomic_fetch_add(p, v, __ATOMIC_RELAXED, __HIP_MEMORY_SCOPE_AGENT); }
DI unsigned xb_xcc_id() { return (unsigned)__builtin_amdgcn_s_getreg((3 << 11) | 20) & 0xFu; }
#define XB_SPIN(cond, bar) do { unsigned _sp = 0; while (cond) { __builtin_amdgcn_s_sleep(1); \
    if ((++_sp & 255u) == 0u) { if (xb_ld(&(bar)[XB_TMO])) break; if (_sp > XB_SPIN_CAP) { atomicAdd(&(bar)[XB_TMO], 1u); break; } } } } while (0)
struct XcdBarrier { unsigned* bar; unsigned x; unsigned nloc, nx; };
DI XcdBarrier xcd_barrier_post(unsigned* bar) {
  XcdBarrier b; b.bar = bar; b.x = xb_xcc_id(); b.nloc = 0u; b.nx = 0u;
  if (threadIdx.x == 0) (void)xb_add(&bar[XB_XCNT(b.x)], 1u);
  return b;
}
DI void xcd_barrier_complete(unsigned* bar, unsigned x, unsigned& nloc, unsigned& nx) {
  const unsigned G = gridDim.x;
  unsigned sum, cnt, mine, sp = 0u;
  for (;;) {
    sum = 0u; cnt = 0u; mine = 0u;
#pragma unroll
    for (unsigned j = 0; j < 16; ++j) { const unsigned c = xb_ld(&bar[XB_XCNT(j)]); sum += c; cnt += (c > 0u) ? 1u : 0u; mine = (j == x) ? c : mine; }
    if (sum == G) break;
    __builtin_amdgcn_s_sleep(1);
    if ((++sp & 255u) == 0u) { if (xb_ld(&bar[XB_TMO])) break; if (sp > XB_SPIN_CAP) { atomicAdd(&bar[XB_TMO], 1u); break; } }
  }
  nloc = mine > 0u ? mine : 1u; nx = cnt > 0u ? cnt : 1u;
}
DI void xcd_barrier(XcdBarrier& b) {
  asm volatile("s_waitcnt vmcnt(0)" ::: "memory");
  if (b.nloc == 0u) {
    unsigned nl, nxx;
    xcd_barrier_complete(b.bar, b.x, nl, nxx);
    b.nloc = __builtin_amdgcn_readfirstlane(nl); b.nx = __builtin_amdgcn_readfirstlane(nxx);
  }
  __syncthreads();
  if (threadIdx.x == 0) {
    unsigned* bar = b.bar;
    __builtin_amdgcn_s_waitcnt(0);
    const unsigned nloc = b.nloc, nx = b.nx;
    const unsigned old = xb_add(&bar[XB_XSUB(b.x)], 1u);
    const unsigned gen = old / nloc;
    if (old + 1u == (gen + 1u) * nloc) {
      __builtin_amdgcn_fence(__ATOMIC_RELEASE, "agent");
      asm volatile("s_waitcnt vmcnt(0)" ::: "memory");
      const unsigned og = xb_add(&bar[XB_TOP], 1u);
      const unsigned tg = og / nx;
      if (og + 1u == (tg + 1u) * nx) xb_add(&bar[XB_TOPGEN], 1u);
      else XB_SPIN(xb_ld(&bar[XB_TOPGEN]) == tg, bar);
      __builtin_amdgcn_fence(__ATOMIC_ACQUIRE, "agent");
      xb_add(&bar[XB_XGEN(b.x)], 1u);
      asm volatile("s_waitcnt vmcnt(0)" ::: "memory");
    } else {
      XB_SPIN(xb_ld(&bar[XB_XGEN(b.x)]) == gen, bar);
      __builtin_amdgcn_fence(__ATOMIC_ACQUIRE, "agent");
      asm volatile("s_waitcnt vmcnt(0)" ::: "memory");
    }
  }
  __syncthreads();
}

__global__ void __launch_bounds__(256, 2) mega(Params p) {
  __shared__ __attribute__((aligned(16))) char lds[65536];
  cg::grid_group grid = cg::this_grid();
  XcdBarrier xb = xcd_barrier_post(p.bar);
#define GRID_SYNC() do { if (p.use_cg) grid.sync(); else xcd_barrier(xb); } while (0)
  phase0(p, lds);
  GRID_SYNC();
  for (int l = 0; l < 4; ++l) {
    phase_inproj(p, l, lds);
#if PROBE_P1
    phase_inproj(p, l, lds);
#endif
    GRID_SYNC();
    phase_attn(p, l, lds);
#if PROBE_B
    if (l == 1) phase_attn(p, l, lds);
#endif
#if PROBE_AC
    if (l != 1) phase_attn(p, l, lds);
#endif
    GRID_SYNC();
    phase_outproj(p, l, lds);
#if PROBE_P3
    if (l == 0) phase_outproj(p, l, lds, true);
#endif
    if (l < 3) GRID_SYNC();
  }
}

extern "C" void kernel_launch(void* const* d_in, const int* in_sizes, int n_in, void* d_out, int out_size, void* d_ws, size_t ws_size, hipStream_t stream) {
  static int grid_blocks = 0;
  if (!grid_blocks) {
    int dev = 0, cus = 0, per_cu = 0;
    (void)hipGetDevice(&dev);
    (void)hipDeviceGetAttribute(&cus, hipDeviceAttributeMultiprocessorCount, dev);
    (void)hipOccupancyMaxActiveBlocksPerMultiprocessor(&per_cu, mega, 256, 0);
    if (per_cu > 2) per_cu = 2;
    grid_blocks = cus * per_cu;
  }
  Params p{};
  p.x = (const float*)d_in[0];
  const int base[4] = {1, 7, 12, 17};
  for (int l = 0; l < 4; ++l) {
    const int b = base[l], hs = (l % 3 == 0) ? 1 : 0;
    p.norm[l] = (const float*)d_in[b]; p.w_in[l] = (const float*)d_in[b + 1]; p.qg[l] = (const float*)d_in[b + 2]; p.kg[l] = (const float*)d_in[b + 3];
    p.sink[l] = hs ? (const float*)d_in[b + 4] : (const float*)d_in[b + 3];
    p.w_out[l] = (const float*)d_in[b + 4 + hs];
  }
  p.out = (float*)d_out;
  char* w = (char*)d_ws; size_t off = 0;
  auto take = [&](size_t bytes) { char* r = w + off; off += (bytes + 255) & ~(size_t)255; return r; };
  p.bar = (unsigned*)take((size_t)XCD_BAR_WORDS * 4); p.use_cg = 0; p.pad0 = 0;
  for (int l = 0; l < 4; ++l) {
    const int kind = l % 3, nin = kind == 2 ? 2816 : 2560, ow = kind == 2 ? 512 : 1024;
    p.wt_in[l] = (bf16_t*)take((size_t)nin * 1024 * 2);
    p.wt_out[l] = (bf16_t*)take((size_t)1024 * ow * 2);
  }
  p.xb = (bf16_t*)take((size_t)S * 1024 * 2);
  p.rs = (float*)take((size_t)4 * S * 4);
  p.Q = (bf16_t*)take((size_t)S * 1536 * 2);
  p.K = (bf16_t*)take((size_t)S * 384 * 2);
  p.Vt = (bf16_t*)take((size_t)6 * 64 * S * 2);
  p.SG = (bf16_t*)take((size_t)S * 1024 * 2);
  p.OG = (bf16_t*)take((size_t)S * 1024 * 2);
  p.rope = (f32x2*)take((size_t)320 * 16 * 8);
  p.wt8 = (unsigned char*)take((size_t)2560 * 1024);
  p.xb8 = (unsigned char*)take((size_t)S * 1024);
  (void)hipMemsetAsync(p.bar, 0, (size_t)XCD_BAR_WORDS * 4, stream);
  void* args[] = {&p};
  hipError_t e = hipLaunchCooperativeKernel((void*)mega, dim3(grid_blocks), dim3(256), args, 0, stream);
  if (e != hipSuccess) fprintf(stderr, "coop launch failed: %s (grid %d)\n", hipGetErrorString(e), grid_blocks);
}
```

```cpp
#include <hip/hip_runtime.h>
#include <hip/hip_cooperative_groups.h>
#include <cstdio>
#ifndef PROBE_P3
#define PROBE_P3 0
#endif
#ifndef PROBE_P1
#define PROBE_P1 0
#endif
#ifndef PROBE_B
#define PROBE_B 0
#endif
#ifndef PROBE_AC
#define PROBE_AC 0
#endif
namespace cg = cooperative_groups;

typedef unsigned short bf16_t;
typedef short bf16x8 __attribute__((ext_vector_type(8)));
typedef float f32x16 __attribute__((ext_vector_type(16)));
typedef float f32x4 __attribute__((ext_vector_type(4)));
typedef float f32x2 __attribute__((ext_vector_type(2)));
typedef unsigned u32x4 __attribute__((ext_vector_type(4)));
typedef unsigned u32x2 __attribute__((ext_vector_type(2)));
typedef __bf16 bf2_t __attribute__((ext_vector_type(2)));
#define DI __device__ __forceinline__
#define MFMA32(a, b, c) __builtin_amdgcn_mfma_f32_32x32x16_bf16((a), (b), (c), 0, 0, 0)

constexpr int S = 16384, DM = 1024;
constexpr float EPS = 1e-6f;
constexpr float LOG2E = 1.4426950408889634f;

struct Params {
  const float* x;
  const float* norm[4]; const float* w_in[4]; const float* qg[4]; const float* kg[4]; const float* sink[4]; const float* w_out[4];
  float* out;
  bf16_t* wt_in[4]; bf16_t* wt_out[4];
  bf16_t* xb; float* rs;
  bf16_t* Q; bf16_t* K; bf16_t* Vt; bf16_t* SG; bf16_t* OG;
  f32x2* rope;
  unsigned char* wt8; unsigned char* xb8;
  unsigned* bar; int use_cg; int pad0;
};

DI unsigned pk_bf16(float a, float b) { f32x2 v = {a, b}; bf2_t r = __builtin_convertvector(v, bf2_t); return __builtin_bit_cast(unsigned, r); }
DI int cvt4_fp8(float a, float b, float c, float d) { int w = __builtin_amdgcn_cvt_pk_fp8_f32(a, b, 0, false); return __builtin_amdgcn_cvt_pk_fp8_f32(c, d, w, true); }
DI int cvt4_bf8(float a, float b, float c, float d) { int w; asm volatile("" : "=v"(w)); w = __builtin_amdgcn_cvt_pk_bf8_f32(a, b, w, false); return __builtin_amdgcn_cvt_pk_bf8_f32(c, d, w, true); }
typedef __attribute__((address_space(3))) unsigned lds_u32;
typedef __attribute__((address_space(1))) const unsigned glb_u32;
DI void glds16(const void* g, char* l) { __builtin_amdgcn_global_load_lds((glb_u32*)g, (lds_u32*)l, 16, 0, 0); }
DI float bf_lo(unsigned w) { return __uint_as_float(w << 16); }
DI float bf_hi(unsigned w) { return __uint_as_float(w & 0xffff0000u); }
DI int nin_of(int kind) { return kind == 2 ? 2816 : 2560; }
DI int outw_of(int kind) { return kind == 2 ? 512 : 1024; }
DI int qw_of(int kind) { return kind == 2 ? 1536 : 1024; }
DI int kvw_of(int kind) { return kind == 2 ? 384 : 256; }
DI int lds_off(int row, int c) { return row * 128 + ((c ^ ((row >> 1) & 7)) << 4); }

struct TJob { const float* src; const float* gain; bf16_t* dst; unsigned char* dst8; int N, K, k0, n0; };
DI TJob tj_decode(const Params& p, int job, const int (&cum)[9]) {
  TJob j{};
#pragma unroll
  for (int l = 0; l < 4; ++l) {
    const int kind = l % 3;
    if (job >= cum[2 * l] && job < cum[2 * l + 1]) {
      const int q = job - cum[2 * l];
      j.src = p.w_in[l]; j.gain = p.norm[l]; j.dst = p.wt_in[l]; j.dst8 = l == 1 ? p.wt8 : nullptr; j.N = nin_of(kind); j.K = 1024; j.k0 = (q & 15) * 64; j.n0 = (q >> 4) * 64;
    } else if (job >= cum[2 * l + 1] && job < cum[2 * l + 2]) {
      const int q = job - cum[2 * l + 1], K = outw_of(kind), nkt = K / 64;
      j.src = p.w_out[l]; j.gain = nullptr; j.dst = p.wt_out[l]; j.N = 1024; j.K = K; j.k0 = (q % nkt) * 64; j.n0 = (q / nkt) * 64;
    }
  }
  return j;
}
DI void tj_load(const TJob& j, float (&v)[16], int tid) {
#pragma unroll
  for (int r = 0; r < 16; ++r) {
    const int kk = r * 4 + (tid >> 6), nn = tid & 63;
    v[r] = j.src[(size_t)(j.k0 + kk) * j.N + j.n0 + nn];
    if (j.gain) v[r] *= j.gain[j.k0 + kk];
  }
}
DI void tj_store(const TJob& j, const float (&v)[16], float* tile, int tid) {
#pragma unroll
  for (int r = 0; r < 16; ++r) tile[(r * 4 + (tid >> 6)) * 65 + (tid & 63)] = v[r];
  __syncthreads();
#pragma unroll
  for (int i = 0; i < 2; ++i) {
    const int nn = (tid >> 3) + 32 * i, kc = (tid & 7) * 8;
    u32x4 w;
    w.x = pk_bf16(tile[(kc + 0) * 65 + nn], tile[(kc + 1) * 65 + nn]);
    w.y = pk_bf16(tile[(kc + 2) * 65 + nn], tile[(kc + 3) * 65 + nn]);
    w.z = pk_bf16(tile[(kc + 4) * 65 + nn], tile[(kc + 5) * 65 + nn]);
    w.w = pk_bf16(tile[(kc + 6) * 65 + nn], tile[(kc + 7) * 65 + nn]);
    if (j.dst8) {
      u32x2 w8;
      w8.x = (unsigned)cvt4_fp8(32.f * tile[(kc + 0) * 65 + nn], 32.f * tile[(kc + 1) * 65 + nn], 32.f * tile[(kc + 2) * 65 + nn], 32.f * tile[(kc + 3) * 65 + nn]);
      w8.y = (unsigned)cvt4_fp8(32.f * tile[(kc + 4) * 65 + nn], 32.f * tile[(kc + 5) * 65 + nn], 32.f * tile[(kc + 6) * 65 + nn], 32.f * tile[(kc + 7) * 65 + nn]);
      *(u32x2*)(j.dst8 + (size_t)(j.n0 + nn) * 1024 + j.k0 + kc) = w8;
    } else {
      *(u32x4*)(j.dst + (size_t)(j.n0 + nn) * j.K + j.k0 + kc) = w;
    }
  }
  __syncthreads();
}

DI void phase0(const Params& p, char* lds) {
  int tid_ = threadIdx.x; asm volatile("" : "+v"(tid_));
  const int tid = tid_, G = gridDim.x, lane = tid & 63, wid = tid >> 6;
  float* tile = (float*)lds;
  int cum[9]; cum[0] = 0;
#pragma unroll
  for (int l = 0; l < 4; ++l) { const int kind = l % 3; cum[2 * l + 1] = cum[2 * l] + 16 * (nin_of(kind) / 64); cum[2 * l + 2] = cum[2 * l + 1] + (outw_of(kind) / 64) * 16; }
  const int total = cum[8];
  if ((int)blockIdx.x < total) {
    float va[16], vb[16];
    TJob ja = tj_decode(p, blockIdx.x, cum), jb{};
    tj_load(ja, va, tid);
    for (int job = blockIdx.x; job < total; job += 2 * G) {
      const bool hb = job + G < total, hc = job + 2 * G < total;
      if (hb) { jb = tj_decode(p, job + G, cum); tj_load(jb, vb, tid); }
      tj_store(ja, va, tile, tid);
      if (hc) { ja = tj_decode(p, job + 2 * G, cum); tj_load(ja, va, tid); }
      if (hb) tj_store(jb, vb, tile, tid);
    }
  }
  for (int r0 = blockIdx.x * 4 + wid; r0 < S; r0 += G * 16) {
    f32x4 v[4][4];
#pragma unroll
    for (int q = 0; q < 4; ++q) {
      const int r = r0 + q * G * 4;
      if (r < S) {
#pragma unroll
        for (int i = 0; i < 4; ++i) v[q][i] = *(const f32x4*)(p.x + (size_t)r * DM + i * 256 + lane * 4);
      }
    }
#pragma unroll
    for (int q = 0; q < 4; ++q) {
      const int r = r0 + q * G * 4;
      if (r < S) {
        float ss = 0.f;
#pragma unroll
        for (int i = 0; i < 4; ++i) {
          const f32x4 x4 = v[q][i];
          ss += x4.x * x4.x + x4.y * x4.y + x4.z * x4.z + x4.w * x4.w;
          u32x2 w; w.x = pk_bf16(x4.x, x4.y); w.y = pk_bf16(x4.z, x4.w);
          *(u32x2*)(p.xb + (size_t)r * DM + i * 256 + lane * 4) = w;
        }
#pragma unroll
        for (int o = 32; o >= 1; o >>= 1) ss += __shfl_xor(ss, o);
        if (lane == 0) p.rs[r] = ss;
        else if (lane < 4) p.rs[lane * S + r] = 0.f;
      }
    }
  }
  for (int gt = blockIdx.x * 256 + tid; gt < 320 * 16; gt += G * 256) {
    const int n = gt >> 4, m = gt & 15, nn = n < 256 ? n : n - 256;
    const double b = sqrt(sqrt(10.0));
    double pw = 1.0;
    for (int i = 0; i < m; ++i) pw *= b;
    const float freq = 1.0f / (float)pw;
    const float ang = (float)nn * freq;
    const double a = (double)ang;
    const double kq = rint(a * 0.15915494309189535);
    double r = fma(-kq, 6.283185307179586, a);
    r = fma(-kq, 2.4492935982947064e-16, r);
    const double r2 = r * r;
    double c = 1.0, s = r, tc = 1.0, ts = r;
    for (int q = 1; q <= 14; ++q) {
      tc *= -r2 / (double)((2 * q - 1) * (2 * q)); c += tc;
      ts *= -r2 / (double)((2 * q) * (2 * q + 1)); s += ts;
    }
    f32x2 o; o.x = (float)c; o.y = (float)s;
    p.rope[gt] = o;
  }
}

typedef int v8i __attribute__((ext_vector_type(8)));
typedef int v6i __attribute__((ext_vector_type(6)));
#ifndef PSCALE
#define PSCALE 1.0f
#endif
#define MFMA6(a, b, c) __builtin_amdgcn_mfma_scale_f32_32x32x64_f8f6f4((a), (b), (c), 2, 3, 0, 127, 0, 127)
DI v8i widen6(v6i a) { return __builtin_shufflevector(a, a, 0, 1, 2, 3, 4, 5, -1, -1); }
DI v8i ld24(const char* p0, const char* p1) {
  const u32x4 a = *(const u32x4*)p0; const u32x2 b = *(const u32x2*)p1;
  v6i r; r[0] = a.x; r[1] = a.y; r[2] = a.z; r[3] = a.w; r[4] = b.x; r[5] = b.y; return widen6(r);
}
#define MFMA8(a, b, c, bfmt) __builtin_amdgcn_mfma_scale_f32_32x32x64_f8f6f4((a), (b), (c), 0, (bfmt), 0, 0, 0, 0)
#define MFMA4(a, b, c) __builtin_amdgcn_mfma_scale_f32_32x32x64_f8f6f4((a), (b), (c), 4, 4, 0, 123, 0, 127)
DI v8i widen4(u32x4 a) { typedef int i4 __attribute__((ext_vector_type(4))); const i4 b = __builtin_bit_cast(i4, a); return __builtin_shufflevector(b, b, 0, 1, 2, 3, -1, -1, -1, -1); }
DI int off8(int row, int c) { return row * 64 + ((c ^ ((row >> 2) & 3)) << 4); }
DI v8i ld32(const char* p0, const char* p1) {
  const u32x4 a = *(const u32x4*)p0, b = *(const u32x4*)p1;
  v8i r; r[0] = a.x; r[1] = a.y; r[2] = a.z; r[3] = a.w; r[4] = b.x; r[5] = b.y; r[6] = b.z; r[7] = b.w; return r;
}

template <bool F8>
DI void gemm_tile(const bf16_t* __restrict__ A, const bf16_t* __restrict__ B, int K, int f0, int t0, char* lds, f32x16 (&acc)[2][2]) {
  int tid_ = threadIdx.x; asm volatile("" : "+v"(tid_));
  const int tid = tid_, lane = tid & 63, wid = tid >> 6, wm = wid >> 1, wn = wid & 1, l32 = lane & 31, h = lane >> 5;
  const int r0 = tid >> 3, c = tid & 7;
#pragma unroll
  for (int i = 0; i < 2; ++i)
#pragma unroll
    for (int j = 0; j < 2; ++j)
#pragma unroll
      for (int r = 0; r < 16; ++r) acc[i][j][r] = 0.f;
  const bf16_t* ag = A + (size_t)(f0 + r0) * K + c * 8;
  const bf16_t* bg = B + (size_t)(t0 + r0) * K + c * 8;
  const int nk = K >> 6;
  u32x4 R0[8], R1[8];
  auto gload = [&](u32x4 (&R)[8], int kt) {
#pragma unroll
    for (int i = 0; i < 4; ++i) { R[i] = *(const u32x4*)(ag + (size_t)(32 * i) * K + kt * 64); R[4 + i] = *(const u32x4*)(bg + (size_t)(32 * i) * K + kt * 64); }
  };
  auto lstore = [&](const u32x4 (&R)[8], int buf) {
    char* d = lds + buf * 32768;
#pragma unroll
    for (int i = 0; i < 4; ++i) { const int off = lds_off(r0 + 32 * i, c); *(u32x4*)(d + off) = R[i]; *(u32x4*)(d + 16384 + off) = R[4 + i]; }
  };
  auto step = [&](int kt, u32x4 (&Ra)[8], const u32x4 (&Rb)[8]) {
    if (kt + 2 < nk) gload(Ra, kt + 2);
    __builtin_amdgcn_sched_barrier(0);
    const char* a = lds + (kt & 1) * 32768;
    const char* b = a + 16384;
    if constexpr (F8) {
#pragma unroll
      for (int ks = 0; ks < 2; ++ks) {
        v8i a8[2], b8[2];
#pragma unroll
        for (int i = 0; i < 2; ++i) {
          a8[i] = ld32(a + lds_off(wm * 64 + i * 32 + l32, 4 * ks + 2 * h), a + lds_off(wm * 64 + i * 32 + l32, 4 * ks + 2 * h + 1));
          b8[i] = ld32(b + lds_off(wn * 64 + i * 32 + l32, 4 * ks + 2 * h), b + lds_off(wn * 64 + i * 32 + l32, 4 * ks + 2 * h + 1));
        }
        __builtin_amdgcn_sched_barrier(0);
#pragma unroll
        for (int i = 0; i < 2; ++i)
#pragma unroll
          for (int j = 0; j < 2; ++j) acc[i][j] = MFMA8(a8[i], b8[j], acc[i][j], 0);
        __builtin_amdgcn_sched_barrier(0);
      }
      if (kt + 1 < nk) lstore(Rb, (kt + 1) & 1);
      __syncthreads();
      return;
    }
    bf16x8 af[2][2], bf[2][2];
#pragma unroll
    for (int i = 0; i < 2; ++i) { af[0][i] = *(const bf16x8*)(a + lds_off(wm * 64 + i * 32 + l32, h)); bf[0][i] = *(const bf16x8*)(b + lds_off(wn * 64 + i * 32 + l32, h)); }
#pragma unroll
    for (int kk = 0; kk < 4; ++kk) {
      if (kk < 3) {
#pragma unroll
        for (int i = 0; i < 2; ++i) { af[(kk + 1) & 1][i] = *(const bf16x8*)(a + lds_off(wm * 64 + i * 32 + l32, 2 * (kk + 1) + h)); bf[(kk + 1) & 1][i] = *(const bf16x8*)(b + lds_off(wn * 64 + i * 32 + l32, 2 * (kk + 1) + h)); }
      }
      __builtin_amdgcn_sched_barrier(0);
#pragma unroll
      for (int i = 0; i < 2; ++i)
#pragma unroll
        for (int j = 0; j < 2; ++j) acc[i][j] = MFMA32(af[kk & 1][i], bf[kk & 1][j], acc[i][j]);
      __builtin_amdgcn_sched_barrier(0);
    }
    if (kt + 1 < nk) lstore(Rb, (kt + 1) & 1);
    __syncthreads();
  };
  gload(R0, 0);
  gload(R1, 1);
  __syncthreads();
  lstore(R0, 0);
  __syncthreads();
#pragma unroll 1
  for (int kt = 0; kt < nk; kt += 2) { step(kt, R0, R1); step(kt + 1, R1, R0); }
}

DI void phase_inproj(const Params& p, int l, char* lds) {
  const int kind = l % 3, NIN = nin_of(kind), NF = NIN / 128, QW = qw_of(kind), KVW = kvw_of(kind), OW = outw_of(kind);
  const int nqh = QW / 64, nkh = KVW / 64;
  int tid_ = threadIdx.x; asm volatile("" : "+v"(tid_));
  const int tid = tid_, lane = tid & 63, wid = tid >> 6, wm = wid >> 1, wn = wid & 1, l32 = lane & 31, h = lane >> 5;
  const float* rs = p.rs + l * S;
  const int ntiles = NF * (S / 128);
  for (int idx = blockIdx.x; idx < ntiles; idx += gridDim.x) {
    const int ti = idx / NF, fi = idx - ti * NF; int f0 = fi * 128, t0 = ti * 128;
    f32x16 acc[2][2];
    if (l == 1) gemm_tile<true>((const bf16_t*)p.wt8, (const bf16_t*)p.xb8, 512, f0, t0, lds, acc);
    else gemm_tile<false>(p.wt_in[l], p.xb, 1024, f0, t0, lds, acc);
    asm volatile("" : "+s"(t0), "+s"(f0));
    const int hb = (f0 >> 6) + wm;
    char* wl = lds + wid * (kind == 1 ? 16384 : 9216);
#pragma unroll
    for (int j = 0; j < 2; ++j) {
      const int t = t0 + wn * 64 + j * 32 + l32;
      const float rsc = __builtin_amdgcn_rsqf(rs[t] * (1.0f / 1024.0f) + EPS) * (l == 1 ? 0.03125f : 1.0f);
      float v[2][16];
#pragma unroll
      for (int i = 0; i < 2; ++i)
#pragma unroll
        for (int r = 0; r < 16; ++r) v[i][r] = acc[i][j][r] * rsc;
      if (hb < nqh + nkh) {
        const bool isq = hb < nqh;
        const float* gain = isq ? p.qg[l] : p.kg[l];
        float ss = 0.f;
#pragma unroll
        for (int i = 0; i < 2; ++i)
#pragma unroll
          for (int r = 0; r < 16; ++r) ss += v[i][r] * v[i][r];
        ss += __shfl_xor(ss, 32);
        const float nrm = __builtin_amdgcn_rsqf(ss * (1.0f / 64.0f) + EPS) * (isq ? 0.125f * LOG2E : 1.0f);
#pragma unroll
        for (int i = 0; i < 2; ++i)
#pragma unroll
          for (int g = 0; g < 4; ++g) {
            const f32x4 gv = *(const f32x4*)(gain + 32 * i + 8 * g + 4 * h);
            v[i][4 * g + 0] *= nrm * gv.x; v[i][4 * g + 1] *= nrm * gv.y; v[i][4 * g + 2] *= nrm * gv.z; v[i][4 * g + 3] *= nrm * gv.w;
          }
        if (kind == 1) {
#pragma unroll
          for (int i = 0; i < 2; ++i) {
            const f32x2* tab = p.rope + (i == 0 ? (t >> 6) : (256 + (t & 63))) * 16;
#pragma unroll
            for (int g = 0; g < 4; ++g)
#pragma unroll
              for (int e = 0; e < 2; ++e) {
                const f32x2 cs = tab[4 * g + 2 * h + e];
                const float x1 = v[i][4 * g + 2 * e], x2 = v[i][4 * g + 2 * e + 1];
                v[i][4 * g + 2 * e] = x1 * cs.x - x2 * cs.y;
                v[i][4 * g + 2 * e + 1] = x1 * cs.y + x2 * cs.x;
              }
          }
        }
        if (kind == 1) {
          const int mexp = isq ? 3 : 1;
          u32x4 w4;
#pragma unroll
          for (int i = 0; i < 2; ++i)
#pragma unroll
            for (int gp = 0; gp < 2; ++gp) {
              unsigned w = 0;
              const int r8 = 8 * gp;
              w = __builtin_amdgcn_cvt_scalef32_pk_fp4_f32(w, __builtin_ldexpf(v[i][r8 + 0], mexp), __builtin_ldexpf(v[i][r8 + 1], mexp), 1.0f, 0);
              w = __builtin_amdgcn_cvt_scalef32_pk_fp4_f32(w, __builtin_ldexpf(v[i][r8 + 2], mexp), __builtin_ldexpf(v[i][r8 + 3], mexp), 1.0f, 1);
              w = __builtin_amdgcn_cvt_scalef32_pk_fp4_f32(w, __builtin_ldexpf(v[i][r8 + 4], mexp), __builtin_ldexpf(v[i][r8 + 5], mexp), 1.0f, 2);
              w = __builtin_amdgcn_cvt_scalef32_pk_fp4_f32(w, __builtin_ldexpf(v[i][r8 + 6], mexp), __builtin_ldexpf(v[i][r8 + 7], mexp), 1.0f, 3);
              w4[2 * i + gp] = w;
            }
          unsigned char* qk4 = isq ? (unsigned char*)p.Q + ((size_t)hb * S + t) * 32 : (unsigned char*)p.K + ((size_t)(hb - nqh) * S + t) * 32;
          *(u32x4*)(qk4 + h * 16) = w4;
        } else {
#pragma unroll
          for (int i = 0; i < 2; ++i)
#pragma unroll
            for (int g = 0; g < 4; ++g) {
              u32x2 w; w.x = pk_bf16(v[i][4 * g], v[i][4 * g + 1]); w.y = pk_bf16(v[i][4 * g + 2], v[i][4 * g + 3]);
              *(u32x2*)(wl + (j * 32 + l32) * 144 + (32 * i + 8 * g + 4 * h) * 2) = w;
            }
        }
      } else if (hb < nqh + 2 * nkh) {
        if (kind == 1) {
#pragma unroll
          for (int i = 0; i < 2; ++i)
#pragma unroll
            for (int r = 0; r < 16; ++r) {
              const int d = 32 * i + 8 * (r >> 2) + 4 * h + (r & 3), tl = j * 32 + l32;
              *(float*)(wl + d * 256 + (((tl >> 2) ^ (d & 15)) << 4) + (tl & 3) * 4) = v[i][r];
            }
        } else
#pragma unroll
        for (int i = 0; i < 2; ++i)
#pragma unroll
          for (int r = 0; r < 16; r += 2) {
            const unsigned w = pk_bf16(v[i][r], v[i][r + 1]);
            const int d = 32 * i + 8 * (r >> 2) + 4 * h + (r & 3);
            *(bf16_t*)(wl + d * 132 + (j * 32 + l32) * 2) = (bf16_t)(w & 0xffff);
            *(bf16_t*)(wl + (d + 1) * 132 + (j * 32 + l32) * 2) = (bf16_t)(w >> 16);
          }
      } else {
#pragma unroll
        for (int i = 0; i < 2; ++i)
#pragma unroll
          for (int g = 0; g < 4; ++g) {
            float s4[4];
#pragma unroll
            for (int e = 0; e < 4; ++e) { const float u = v[i][4 * g + e]; s4[e] = u * __builtin_amdgcn_rcpf(1.0f + __builtin_amdgcn_exp2f(-u * LOG2E)); }
            u32x2 w; w.x = pk_bf16(s4[0], s4[1]); w.y = pk_bf16(s4[2], s4[3]);
            *(u32x2*)(wl + (j * 32 + l32) * 144 + (32 * i + 8 * g + 4 * h) * 2) = w;
          }
      }
    }
    const int tb = t0 + wn * 64;
    if (kind == 1 && hb < nqh + 2 * nkh) {
      if (hb < nqh + nkh) {
      } else {
        unsigned char* vbase = (unsigned char*)p.Vt + ((size_t)(hb - nqh - nkh) * 256 + (tb >> 6)) * 4096;
#pragma unroll 1
        for (int hh = 0; hh < 2; ++hh) {
          const int d = lane;
          f32x16 va, vb2;
#pragma unroll
          for (int g = 0; g < 4; ++g) {
            const f32x4 x0 = *(const f32x4*)(wl + d * 256 + (((2 * g + hh) ^ (d & 15)) << 4));
            const f32x4 x1 = *(const f32x4*)(wl + d * 256 + (((8 + 2 * g + hh) ^ (d & 15)) << 4));
            va[4 * g] = x0.x; va[4 * g + 1] = x0.y; va[4 * g + 2] = x0.z; va[4 * g + 3] = x0.w;
            vb2[4 * g] = x1.x; vb2[4 * g + 1] = x1.y; vb2[4 * g + 2] = x1.z; vb2[4 * g + 3] = x1.w;
          }
          const v6i w6 = __builtin_amdgcn_cvt_scalef32_2xpk16_fp6_f32(va, vb2, 1.0f);
          unsigned char* dst = vbase + d * 64 + hh * 32;
          u32x4 lo4; lo4.x = w6[0]; lo4.y = w6[1]; lo4.z = w6[2]; lo4.w = w6[3];
          u32x2 hi2; hi2.x = w6[4]; hi2.y = w6[5];
          *(u32x4*)dst = lo4; *(u32x2*)(dst + 16) = hi2;
        }
      }
    } else if (hb >= nqh + nkh && hb < nqh + 2 * nkh) {
      const int slot = hb - nqh - nkh;
      const int dsh = kind == 2 ? 2 * (slot >> 1) : 0, dil = 1 << dsh;
      bf16_t* vbase = p.Vt + (size_t)slot * 64 * S;
#pragma unroll 4
      for (int ps = 0; ps < 16; ++ps) {
        const int u = ps * 64 + lane, d = u >> 4, m = u & 15, c = m & (dil - 1), kq = m >> dsh;
        const char* src = wl + d * 132 + (c + dil * 4 * kq) * 2;
        const unsigned a0 = *(const bf16_t*)(src), a1 = *(const bf16_t*)(src + dil * 2), a2 = *(const bf16_t*)(src + dil * 4), a3 = *(const bf16_t*)(src + dil * 6);
        u32x2 w; w.x = a0 | (a1 << 16); w.y = a2 | (a3 << 16);
        const int pi = (c << (14 - dsh)) + (tb >> dsh) + 4 * kq;
        const int lo = pi & 15, pos = (pi & ~15) | (lo & 3) | (((lo >> 2) & 1) << 3) | (((lo >> 3) & 1) << 2);
        *(u32x2*)(vbase + (size_t)(pos >> 6) * 4096 + d * 64 + (pos & 63)) = w;
      }
    } else {
      bf16_t* dbase; size_t pitch;
      if (hb < nqh) { dbase = p.Q + (size_t)tb * QW + hb * 64; pitch = QW; }
      else if (hb < nqh + nkh) { dbase = p.K + ((size_t)(hb - nqh) * S + tb) * 64; pitch = 64; }
      else { dbase = p.SG + (size_t)tb * OW + (hb - nqh - 2 * nkh) * 64; pitch = OW; }
#pragma unroll
      for (int ps = 0; ps < 8; ++ps) {
        const int row = ps * 8 + (lane >> 3), ch = lane & 7;
        const u32x4 val = *(const u32x4*)(wl + row * 144 + ch * 16);
        *(u32x4*)(dbase + (size_t)row * pitch + ch * 8) = val;
      }
    }
  }
}

DI void phase_outproj(const Params& p, int l, char* lds, bool dry = false) {
  const int kind = l % 3, OW = outw_of(kind);
  int tid_ = threadIdx.x; asm volatile("" : "+v"(tid_));
  const int tid = tid_, lane = tid & 63, wid = tid >> 6, wm = wid >> 1, wn = wid & 1, l32 = lane & 31, h = lane >> 5;
  const float* xres = l == 0 ? p.x : p.out;
  float* rsn = p.rs + (l + 1) * S;
  const int ntiles = 8 * (S / 128);
  for (int idx = blockIdx.x; idx < ntiles; idx += gridDim.x) {
    const int ti = idx >> 3, fi = idx & 7; int f0 = fi * 128, t0 = ti * 128;
    f32x16 acc[2][2];
    gemm_tile<false>(p.wt_out[l], p.OG, OW, f0, t0, lds, acc);
    asm volatile("" : "+s"(t0), "+s"(f0));
    char* wl = lds + wid * 8704;
#pragma unroll
    for (int j = 0; j < 2; ++j) {
#pragma unroll
      for (int i = 0; i < 2; ++i)
#pragma unroll
        for (int g = 0; g < 4; ++g) {
          f32x4 a; a.x = acc[i][j][4 * g]; a.y = acc[i][j][4 * g + 1]; a.z = acc[i][j][4 * g + 2]; a.w = acc[i][j][4 * g + 3];
          *(f32x4*)(wl + l32 * 272 + (32 * i + 8 * g + 4 * h) * 4) = a;
        }
#pragma unroll
      for (int ps = 0; ps < 8; ++ps) {
        const int row = ps * 4 + (lane >> 4), ch = lane & 15;
        const f32x4 a = *(const f32x4*)(wl + row * 272 + ch * 16);
        const int t = t0 + wn * 64 + j * 32 + row;
        const size_t o = (size_t)t * DM + f0 + wm * 64 + ch * 4;
        f32x4 xv = *(const f32x4*)(xres + o);
        xv.x += a.x; xv.y += a.y; xv.z += a.z; xv.w += a.w;
        *(f32x4*)(p.out + o) = xv;
        if (l < 3) {
          if (l == 0) { *(int*)(p.xb8 + o) = cvt4_fp8(xv.x, xv.y, xv.z, xv.w); }
          else { u32x2 w; w.x = pk_bf16(xv.x, xv.y); w.y = pk_bf16(xv.z, xv.w); *(u32x2*)(p.xb + o) = w; }
          float ss = xv.x * xv.x + xv.y * xv.y + xv.z * xv.z + xv.w * xv.w;
          ss += __shfl_xor(ss, 1); ss += __shfl_xor(ss, 2); ss += __shfl_xor(ss, 4); ss += __shfl_xor(ss, 8);
          if (ch == 0 && !dry) atomicAdd(rsn + t, ss);
        }
      }
    }
  }
}

template <bool MASKED>
DI void attn_group(const bf16_t* __restrict__ Qp, int qld, const bf16_t* __restrict__ Kp, int kld, const bf16_t* __restrict__ Vtp,
                   int T0, int qs, int dsh, int W, float slope_c, float sc, float Mc, f32x16 (&oacc)[2], float& lsum, char* lds) {
  int tid_ = threadIdx.x; asm volatile("" : "+v"(tid_));
  const int tid = tid_, lane = tid & 63, wid = tid >> 6, l32 = lane & 31, h = lane >> 5;
  const int dil = 1 << dsh, L = S >> dsh, c_d = T0 & (dil - 1), U0 = T0 >> dsh;
  const int tq = T0 + qs * (wid * 32 + l32);
  const int tq_lo = T0 + qs * (wid * 32), tq_hi = tq_lo + qs * 31;
  bf16x8 qf[4];
#pragma unroll
  for (int kk = 0; kk < 4; ++kk) qf[kk] = *(const bf16x8*)(Qp + (size_t)tq * qld + 16 * kk + 8 * h);
  int Ub = 0, Ue = S;
  if (MASKED) {
    const int Wd = W >> dsh, lo = U0 - Wd, hi = U0 + (qs >> dsh) * 127 + Wd + 1;
    Ub = lo < 0 ? 0 : (lo & ~63);
    Ue = hi < L ? hi : L;
  }
  const int ntiles = (Ue - Ub + 63) >> 6;
  const int r0 = tid >> 3, c = tid & 7;
  const bf16_t* kg = Kp + (size_t)(c_d + dil * (Ub + r0)) * kld + c * 8;
  const size_t kstep32 = (size_t)(dil * 32) * kld, kstep64 = (size_t)(dil * 64) * kld;
  const bf16_t* vg = Vtp + (size_t)((c_d * L + Ub) >> 6) * 4096 + r0 * 64 + c * 8;
  u32x4 R0[4], R1[4];
  auto gload = [&](u32x4 (&R)[4], int t) {
#pragma unroll
    for (int i = 0; i < 2; ++i) { R[i] = *(const u32x4*)(kg + t * kstep64 + i * kstep32); R[2 + i] = *(const u32x4*)(vg + 2048 * i + (size_t)t * 4096); }
  };
  auto lstore = [&](const u32x4 (&R)[4], int buf) {
    char* d = lds + buf * 16384;
#pragma unroll
    for (int i = 0; i < 2; ++i) { const int off = lds_off(r0 + 32 * i, c); *(u32x4*)(d + off) = R[i]; *(u32x4*)(d + 8192 + off) = R[2 + i]; }
  };
  auto step = [&](int t, u32x4 (&Ra)[4], const u32x4 (&Rb)[4]) {
    if (t + 2 < ntiles) gload(Ra, t + 2);
    __builtin_amdgcn_sched_barrier(0);
    const int tile_tok0 = c_d + dil * (Ub + 64 * t);
    bool active = true;
    if (MASKED) active = !(tile_tok0 > tq_hi + W || tile_tok0 + dil * 63 < tq_lo - W);
    if (active) {
      const char* kb = lds + (t & 1) * 16384;
      const char* vb = kb + 8192;
      f32x16 sacc[2];
#pragma unroll
      for (int kt = 0; kt < 2; ++kt)
#pragma unroll
        for (int r = 0; r < 16; ++r) sacc[kt][r] = -Mc;
      bf16x8 kf[2][4];
#pragma unroll
      for (int kk = 0; kk < 4; ++kk)
#pragma unroll
        for (int kt = 0; kt < 2; ++kt) kf[kt][kk] = *(const bf16x8*)(kb + lds_off(32 * kt + l32, 2 * kk + h));
      __builtin_amdgcn_sched_barrier(0);
#pragma unroll
      for (int kk = 0; kk < 4; ++kk)
#pragma unroll
        for (int kt = 0; kt < 2; ++kt) sacc[kt] = MFMA32(kf[kt][kk], qf[kk], sacc[kt]);
      bf16x8 vf[4][2];
#pragma unroll
      for (int s = 0; s < 4; ++s)
#pragma unroll
        for (int i = 0; i < 2; ++i) vf[s][i] = *(const bf16x8*)(vb + lds_off(32 * i + l32, 2 * s + h));
      __builtin_amdgcn_sched_barrier(0);
      if (MASKED) {
        const float Wf = (float)W, ndil = -(float)dil;
        const float nd1 = __uint_as_float(__builtin_amdgcn_readfirstlane(__float_as_uint(ndil)));
        const float nd2 = __uint_as_float(__builtin_amdgcn_readfirstlane(__float_as_uint(2.f * ndil)));
        const float nd3 = __uint_as_float(__builtin_amdgcn_readfirstlane(__float_as_uint(3.f * ndil)));
        const float nd8 = __uint_as_float(__builtin_amdgcn_readfirstlane(__float_as_uint(8.f * ndil)));
        float dg = (float)(tq - tile_tok0 - dil * 4 * h);
#pragma unroll
        for (int kt = 0; kt < 2; ++kt)
#pragma unroll
          for (int g = 0; g < 4; ++g) {
            const float d4[4] = {dg, dg + nd1, dg + nd2, dg + nd3};
#pragma unroll
            for (int e = 0; e < 4; ++e) {
              const float ex = __builtin_amdgcn_exp2f(__builtin_fmaf(-slope_c, __builtin_fabsf(d4[e]), sacc[kt][4 * g + e]));
              const float pv = __builtin_fabsf(d4[e]) <= Wf ? ex : 0.f;
              lsum += pv;
              sacc[kt][4 * g + e] = pv;
            }
            dg += nd8;
          }
      } else {
#pragma unroll
        for (int kt = 0; kt < 2; ++kt)
#pragma unroll
          for (int r = 0; r < 16; ++r) { const float pv = __builtin_amdgcn_exp2f(sacc[kt][r]); lsum += pv; sacc[kt][r] = pv; }
      }
#pragma unroll
      for (int s = 0; s < 4; ++s) {
        u32x4 pw;
        const int kt = s >> 1, b = 8 * (s & 1);
        pw.x = pk_bf16(sacc[kt][b + 0], sacc[kt][b + 1]); pw.y = pk_bf16(sacc[kt][b + 2], sacc[kt][b + 3]);
        pw.z = pk_bf16(sacc[kt][b + 4], sacc[kt][b + 5]); pw.w = pk_bf16(sacc[kt][b + 6], sacc[kt][b + 7]);
        const bf16x8 pf = __builtin_bit_cast(bf16x8, pw);
#pragma unroll
        for (int i = 0; i < 2; ++i) oacc[i] = MFMA32(vf[s][i], pf, oacc[i]);
      }
    }
    __builtin_amdgcn_sched_barrier(0);
    if (t + 1 < ntiles) lstore(Rb, (t + 1) & 1);
    __syncthreads();
  };
  gload(R0, 0);
  if (ntiles > 1) gload(R1, 1);
  lstore(R0, 0);
  __syncthreads();
#pragma unroll 1
  for (int t = 0; t < ntiles; t += 2) { step(t, R0, R1); if (t + 1 < ntiles) step(t + 1, R1, R0); }
}


DI void attn_dense_fast(const bf16_t* __restrict__ Qp, const bf16_t* __restrict__ Kp, const bf16_t* __restrict__ Vtp, int T0,
                        f32x16 (&oacc)[2], float& lsum, char* lds) {
  int tid_ = threadIdx.x; asm volatile("" : "+v"(tid_));
  const int tid = tid_, lane = tid & 63, wid = tid >> 6, l32 = lane & 31, h = lane >> 5;
  const int tq = T0 + wid * 32 + l32;
  bf16x8 qf[4];
#pragma unroll
  for (int kk = 0; kk < 4; ++kk) qf[kk] = *(const bf16x8*)(Qp + (size_t)tq * 1024 + 16 * kk + 8 * h);
  const int r0 = tid >> 3, c = tid & 7;
  const bf16_t* kg = Kp + (size_t)r0 * 64 + c * 8;
  const bf16_t* vg = Vtp + r0 * 64 + c * 8;
  constexpr int n = S / 64;
  u32x4 R0[4], R1[4];
  auto gload = [&](u32x4 (&R)[4], int t) {
#pragma unroll
    for (int i = 0; i < 2; ++i) { R[i] = *(const u32x4*)(kg + (size_t)(t * 64 + 32 * i) * 64); R[2 + i] = *(const u32x4*)(vg + 2048 * i + (size_t)t * 4096); }
  };
  auto lstore = [&](const u32x4 (&R)[4], int buf) {
    char* d = lds + buf * 16384;
#pragma unroll
    for (int i = 0; i < 2; ++i) { const int off = lds_off(r0 + 32 * i, c); *(u32x4*)(d + off) = R[i]; *(u32x4*)(d + 8192 + off) = R[2 + i]; }
  };
  int koff[4], voff[2][2];
#pragma unroll
  for (int kk = 0; kk < 4; ++kk) koff[kk] = lds_off(l32, 2 * kk + h);
  f32x16 SA, SB;
  float ls0 = 0.f, ls1 = 0.f;
  bf16x8 kf[4];
  bf16x8 vf[2][2];
  bf16x8 pf[2];
#define FENCE() __builtin_amdgcn_sched_barrier(0)
#define EX(i) pv[i] = __builtin_amdgcn_exp2f(Sc[i])
  auto half = [&](const f32x16& Sc, f32x16& Sn, const char* knext, const char* vcur, int hv) {
    f32x16 z;
#pragma unroll
    for (int r = 0; r < 16; ++r) z[r] = 0.f;
    float pv[16];
    u32x4 pw0, pw1;
    const int vo00 = lds_off(l32, 2 * (2 * hv) + h), vo01 = lds_off(32 + l32, 2 * (2 * hv) + h);
    const int vo10 = lds_off(l32, 2 * (2 * hv + 1) + h), vo11 = lds_off(32 + l32, 2 * (2 * hv + 1) + h);
    FENCE();
    Sn = MFMA32(kf[0], qf[0], z);               kf[0] = *(const bf16x8*)(knext + koff[0]);  EX(0); EX(1); EX(2);      FENCE();
    oacc[0] = MFMA32(vf[0][0], pf[0], oacc[0]); vf[0][0] = *(const bf16x8*)(vcur + vo00);   EX(3); EX(4); EX(5);      FENCE();
    Sn = MFMA32(kf[1], qf[1], Sn);              kf[1] = *(const bf16x8*)(knext + koff[1]);  EX(6); EX(7); EX(8);      FENCE();
    oacc[1] = MFMA32(vf[0][1], pf[0], oacc[1]); vf[0][1] = *(const bf16x8*)(vcur + vo01);   EX(9); EX(10); EX(11);    FENCE();
    Sn = MFMA32(kf[2], qf[2], Sn);              kf[2] = *(const bf16x8*)(knext + koff[2]);  EX(12); EX(13); EX(14); EX(15); FENCE();
    oacc[0] = MFMA32(vf[1][0], pf[1], oacc[0]); vf[1][0] = *(const bf16x8*)(vcur + vo10);
    pw0.x = pk_bf16(pv[0], pv[1]); pw0.y = pk_bf16(pv[2], pv[3]); pw0.z = pk_bf16(pv[4], pv[5]); pw0.w = pk_bf16(pv[6], pv[7]);
    ls0 += pv[0]; ls1 += pv[1];                                                                                        FENCE();
    Sn = MFMA32(kf[3], qf[3], Sn);              kf[3] = *(const bf16x8*)(knext + koff[3]);
    pw1.x = pk_bf16(pv[8], pv[9]); pw1.y = pk_bf16(pv[10], pv[11]); pw1.z = pk_bf16(pv[12], pv[13]); pw1.w = pk_bf16(pv[14], pv[15]);
    ls0 += pv[2]; ls1 += pv[3];                                                                                        FENCE();
    oacc[1] = MFMA32(vf[1][1], pf[1], oacc[1]); vf[1][1] = *(const bf16x8*)(vcur + vo11);
    ls0 += pv[4]; ls1 += pv[5]; ls0 += pv[6]; ls1 += pv[7]; ls0 += pv[8]; ls1 += pv[9]; ls0 += pv[10]; ls1 += pv[11]; ls0 += pv[12]; ls1 += pv[13]; ls0 += pv[14]; ls1 += pv[15];
    asm volatile("" : "+v"(ls0), "+v"(ls1));
    FENCE();
    pf[0] = __builtin_bit_cast(bf16x8, pw0); pf[1] = __builtin_bit_cast(bf16x8, pw1);
  };
  gload(R0, 0);
  gload(R1, 1);
  lstore(R0, 0);
  lstore(R1, 1);
  gload(R0, 2);
  __syncthreads();
  {
    f32x16 z;
#pragma unroll
    for (int r = 0; r < 16; ++r) z[r] = 0.f;
    SA = z;
#pragma unroll
    for (int kk = 0; kk < 4; ++kk) SA = MFMA32(*(const bf16x8*)(lds + koff[kk]), qf[kk], SA);
#pragma unroll
    for (int kk = 0; kk < 4; ++kk) kf[kk] = *(const bf16x8*)(lds + 4096 + koff[kk]);
    const u32x4 zz = {0u, 0u, 0u, 0u};
    pf[0] = __builtin_bit_cast(bf16x8, zz); pf[1] = pf[0];
#pragma unroll
    for (int s = 0; s < 2; ++s)
#pragma unroll
      for (int i = 0; i < 2; ++i) vf[s][i] = *(const bf16x8*)(lds + 8192 + lds_off(32 * i + l32, 2 * s + h));
  }
  int bcur = 0;
  auto tile = [&](int t, u32x4 (&Rload)[4], const u32x4 (&Rstore)[4]) {
    if (t + 3 < n) gload(Rload, t + 3);
    FENCE();
    const int bnext = bcur == 2 ? 0 : bcur + 1, bwr = bnext == 2 ? 0 : bnext + 1;
    const char* cur = lds + bcur * 16384;
    const char* nxt = lds + bnext * 16384;
    half(SA, SB, nxt, cur + 8192, 0);
    half(SB, SA, nxt + 4096, cur + 8192, 1);
    if (t + 2 < n) lstore(Rstore, bwr);
    bcur = bnext;
    __syncthreads();
  };
#pragma unroll 1
  for (int t = 0; t < n; t += 2) { tile(t, R1, R0); tile(t + 1, R0, R1); }
#pragma unroll
  for (int s = 0; s < 2; ++s)
#pragma unroll
    for (int i = 0; i < 2; ++i) oacc[i] = MFMA32(vf[s][i], pf[s], oacc[i]);
  lsum += ls0 + ls1;
}


template <bool SHIFTED>
DI void attn_dense_fp8(const unsigned char* __restrict__ Qp, const unsigned char* __restrict__ Kp, const unsigned char* __restrict__ Vp, int T0, float shift,
                       f32x16 (&oacc)[2], float& lsum, char* lds) {
  int tid_ = threadIdx.x; asm volatile("" : "+v"(tid_));
  const int tid = tid_, lane = tid & 63, wid = tid >> 6, l32 = lane & 31, h = lane >> 5;
  const int tq = T0 + wid * 32 + l32;
  const v8i qf = widen4(*(const u32x4*)(Qp + (size_t)tq * 32 + h * 16));
  const int lr = tid >> 2, lc = (tid & 3) ^ ((lr >> 2) & 3);
  const unsigned goff = (unsigned)(lr * 64 + lc * 16);
#define kg (Kp + goff)
#define vg (Vp + goff)
  constexpr int n = S / 64;
  const int kP = (wid & 1) * 64 + lane, krow = kP >> 1, kc = (kP & 1) ^ ((krow >> 3) & 1);
  const unsigned koff4 = (unsigned)(krow * 32 + kc * 16);
  int fo4[2];
#pragma unroll
  for (int x = 0; x < 2; ++x) fo4[x] = (32 * x + l32) * 32 + ((h ^ ((l32 >> 3) & 1)) << 4);
  int fo[2][2];
#pragma unroll
  for (int x = 0; x < 2; ++x) { fo[x][0] = off8(32 * x + l32, 2 * h); fo[x][1] = off8(32 * x + l32, 2 * h + 1); }
  f32x16 zs;
#pragma unroll
  for (int r = 0; r < 16; ++r) zs[r] = 0.f;
  f32x16 SA[2], SB[2];
  v8i kf[2], vf[2], pf;
  float ls0 = 0.f, ls1 = 0.f;
#define FENCE() __builtin_amdgcn_sched_barrier(0)
#define EXA(i) pa[i] = __builtin_amdgcn_exp2f(SHIFTED ? Sc[0][i] - shift : Sc[0][i])
#define EXB(i) pb[i] = __builtin_amdgcn_exp2f(SHIFTED ? Sc[1][i] - shift : Sc[1][i])
  auto tile = [&](const f32x16 (&Sc)[2], f32x16 (&Sn)[2], const char* k2, const char* v0) {
    f32x16 pa, pb;
    FENCE();
    Sn[0] = MFMA4(kf[0], qf, zs);
    EXA(0); EXA(1); EXA(2); EXA(3); EXA(4); EXA(5); EXA(6); EXA(7); EXA(8); EXA(9); EXA(10);                     FENCE();
    oacc[0] = MFMA6(vf[0], pf, oacc[0]);        kf[0] = widen4(*(const u32x4*)(k2 + fo4[0]));
    EXA(11); EXA(12); EXA(13); EXA(14); EXA(15); EXB(0); EXB(1); EXB(2); EXB(3); EXB(4); EXB(5);
#pragma unroll
    for (int r = 0; r < 16; r += 2) { ls0 += pa[r]; ls1 += pa[r + 1]; }
    asm volatile("" : "+v"(ls0), "+v"(ls1));                                                                    FENCE();
    Sn[1] = MFMA4(kf[1], qf, zs);               vf[0] = ld24(v0 + fo[0][0], v0 + (fo[0][0] ^ 16));
    EXB(6); EXB(7); EXB(8); EXB(9); EXB(10); EXB(11); EXB(12); EXB(13); EXB(14); EXB(15);                         FENCE();
    oacc[1] = MFMA6(vf[1], pf, oacc[1]);        kf[1] = widen4(*(const u32x4*)(k2 + fo4[1]));
    FENCE();
    vf[1] = ld24(v0 + fo[1][0], v0 + (fo[1][0] ^ 16));
    const v6i pn6 = __builtin_amdgcn_cvt_scalef32_2xpk16_bf6_f32(pa, pb, PSCALE);
#pragma unroll
    for (int r = 0; r < 16; r += 2) { ls0 += pb[r]; ls1 += pb[r + 1]; }
    asm volatile("" : "+v"(ls0), "+v"(ls1));
    FENCE();
    pf = widen6(pn6);
  };
  auto tbase = [&](int k) { return ((k >> 1) & 3) * 16384 + (k & 1) * 8192; };
  auto dmat = [&](int k) {
    char* d = lds + tbase(k);
    glds16(Vp + (size_t)k * 4096 + goff, d + 4096 + tid * 16);
    glds16(Kp + (size_t)k * 2048 + koff4, d + kP * 16);
  };
  dmat(0); dmat(1); dmat(2); dmat(3); dmat(4); dmat(5);
  asm volatile("s_waitcnt vmcnt(0)" ::: "memory");
  __builtin_amdgcn_s_barrier();
  {
    kf[0] = widen4(*(const u32x4*)(lds + fo4[0])); kf[1] = widen4(*(const u32x4*)(lds + fo4[1]));
    SA[0] = MFMA4(kf[0], qf, zs); SA[1] = MFMA4(kf[1], qf, zs);
    kf[0] = widen4(*(const u32x4*)(lds + 8192 + fo4[0])); kf[1] = widen4(*(const u32x4*)(lds + 8192 + fo4[1]));
    vf[0] = ld24(lds + 4096 + fo[0][0], lds + 4096 + (fo[0][0] ^ 16)); vf[1] = ld24(lds + 4096 + fo[1][0], lds + 4096 + (fo[1][0] ^ 16));
#pragma unroll
    for (int w = 0; w < 8; ++w) pf[w] = 0;
  }
#pragma unroll 1
  for (int t8 = 0; t8 < n; t8 += 8) {
#pragma unroll 1
    for (int u = 0; u < 4; ++u) {
      const int t = t8 + 2 * u;
      const bool more = t + 6 < n;
      if (more) {
        char* d = lds + ((u + 3) & 3) * 16384;
        glds16(Vp + (size_t)(t + 6) * 4096 + goff, d + 4096 + tid * 16);
        glds16(Vp + (size_t)(t + 7) * 4096 + goff, d + 8192 + 4096 + tid * 16);
        glds16(Kp + (size_t)(t + 6) * 2048 + koff4, d + kP * 16); glds16(Kp + (size_t)(t + 7) * 2048 + koff4, d + 8192 + kP * 16);
      }
      tile(SA, SB, lds + ((u + 1) & 3) * 16384, lds + u * 16384 + 4096);
      tile(SB, SA, lds + ((u + 1) & 3) * 16384 + 8192, lds + u * 16384 + 8192 + 4096);
      if (more) asm volatile("s_waitcnt vmcnt(4) lgkmcnt(0)" ::: "memory");
      else asm volatile("s_waitcnt vmcnt(0) lgkmcnt(0)" ::: "memory");
      __builtin_amdgcn_s_barrier();
    }
  }
  oacc[0] = MFMA6(vf[0], pf, oacc[0]);
  oacc[1] = MFMA6(vf[1], pf, oacc[1]);
  lsum += ls0 + ls1;
#undef EXA
#undef EXB
#undef kg
#undef vg
}

DI float gain_bound(const float* qg, const float* kg) {
  float a = 0.f, b = 0.f;
  for (int i = 0; i < 64; ++i) { a = fmaxf(a, fabsf(qg[i])); b = fmaxf(b, fabsf(kg[i])); }
  return 8.0f * a * b;
}

DI void attn_store(const Params& p, const f32x16 (&oacc)[2], float ltot, int t, int OW, int ocol) {
  const int h = (threadIdx.x & 63) >> 5;
  const float inv = 1.0f / ltot;
#pragma unroll
  for (int i = 0; i < 2; ++i)
#pragma unroll
    for (int g = 0; g < 4; ++g) {
      const size_t o = (size_t)t * OW + ocol + 32 * i + 8 * g + 4 * h;
      const u32x2 sg = *(const u32x2*)(p.SG + o);
      u32x2 w;
      w.x = pk_bf16(oacc[i][4 * g] * inv * bf_lo(sg.x), oacc[i][4 * g + 1] * inv * bf_hi(sg.x));
      w.y = pk_bf16(oacc[i][4 * g + 2] * inv * bf_lo(sg.y), oacc[i][4 * g + 3] * inv * bf_hi(sg.y));
      *(u32x2*)(p.OG + o) = w;
    }
}

DI void phase_attn(const Params& p, int l, char* lds) {
  const int kind = l % 3;
  const int tid = threadIdx.x, lane = tid & 63, wid = tid >> 6, l32 = lane & 31;
  const float bound = gain_bound(p.qg[l], p.kg[l]);
  const float sc = 0.125f * LOG2E;
  if (kind == 0) {
    for (int idx = blockIdx.x; idx < 16 * 128; idx += gridDim.x) {
      const int head = idx & 15, qt = idx >> 4, T0 = qt * 128;
      const float sk = p.sink[l][head], M = fmaxf(bound, sk);
      const float slope = exp2f(-0.5f * (float)(head + 1));
      f32x16 oacc[2]; float lsum = 0.f;
#pragma unroll
      for (int i = 0; i < 2; ++i)
#pragma unroll
        for (int r = 0; r < 16; ++r) oacc[i][r] = 0.f;
      attn_group<true>(p.Q + head * 64, 1024, p.K + (size_t)(head >> 2) * S * 64, 64, p.Vt + (size_t)(head >> 2) * 64 * S, T0, 1, 0, 128, slope * LOG2E, sc, M * LOG2E, oacc, lsum, lds);
      float ltot = lsum + __shfl_xor(lsum, 32);
      ltot += __builtin_amdgcn_exp2f((sk - M) * LOG2E);
      attn_store(p, oacc, ltot, T0 + wid * 32 + l32, 1024, head * 64);
    }
  } else if (kind == 1) {
    for (int idx = blockIdx.x; idx < 16 * 128; idx += gridDim.x) {
      const int kvh = (idx & 7) >> 1, rest = ((idx >> 3) << 1) | (idx & 1), head = kvh * 4 + (rest & 3), qt = rest >> 2, T0 = qt * 128;
      f32x16 oacc[2]; float lsum = 0.f;
#pragma unroll
      for (int i = 0; i < 2; ++i)
#pragma unroll
        for (int r = 0; r < 16; ++r) oacc[i][r] = 0.f;
      const float Mc = bound * LOG2E;
      if (Mc > 14.f) attn_dense_fp8<true>((const unsigned char*)p.Q + (size_t)head * S * 32, (const unsigned char*)p.K + (size_t)kvh * S * 32, (const unsigned char*)p.Vt + (size_t)kvh * 64 * S, T0, Mc - 14.f, oacc, lsum, lds);
      else attn_dense_fp8<false>((const unsigned char*)p.Q + (size_t)head * S * 32, (const unsigned char*)p.K + (size_t)kvh * S * 32, (const unsigned char*)p.Vt + (size_t)kvh * 64 * S, T0, 0.f, oacc, lsum, lds);
      const float ltot = lsum + __shfl_xor(lsum, 32);
      attn_store(p, oacc, ltot, T0 + wid * 32 + l32, 1024, head * 64);
    }
  } else {
    for (int idx = blockIdx.x; idx < 8 * 128; idx += gridDim.x) {
      const int slot = idx & 7, set = idx >> 3, T0 = (set >> 4) * 2048 + (set & 15);
      f32x16 oacc[2]; float lsum = 0.f;
#pragma unroll
      for (int i = 0; i < 2; ++i)
#pragma unroll
        for (int r = 0; r < 16; ++r) oacc[i][r] = 0.f;
      for (int gi = 0; gi < 3; ++gi) {
        const int head = gi * 8 + slot, kvs = gi * 2 + (slot >> 2), dsh = 2 * gi, W = 64 << dsh;
        const float slope = exp2f(-8.0f * (float)(head + 1) / 24.0f);
        attn_group<true>(p.Q + head * 64, 1536, p.K + (size_t)kvs * S * 64, 64, p.Vt + (size_t)kvs * 64 * S, T0, 16, dsh, W, slope * LOG2E, sc, bound * LOG2E, oacc, lsum, lds);
      }
      const float ltot = lsum + __shfl_xor(lsum, 32);
      attn_store(p, oacc, ltot, T0 + 16 * (wid * 32 + l32), 512, slot * 64);
    }
  }
}


#define XB_TMO      128
#define XB_XCNT(j)  (256  + 64 * (j))
#define XB_XSUB(j)  (1280 + 64 * (j))
#define XB_XGEN(j)  (2304 + 64 * (j))
#define XB_TOP      3328
#define XB_TOPGEN   3392
#define XCD_BAR_WORDS 3456
#define XB_SPIN_CAP (1u << 18)
DI unsigned xb_ld(unsigned* p) { return __hip_atomic_load(p, __ATOMIC_RELAXED, __HIP_MEMORY_SCOPE_AGENT); }
DI unsigned xb_add(unsigned* p, unsigned v) { return __hip_atomic_fetch_add(p, v, __ATOMIC_RELAXED, __HIP_MEMORY_SCOPE_AGENT); }
DI unsigned xb_xcc_id() { return (unsigned)__builtin_amdgcn_s_getreg((3 << 11) | 20) & 0xFu; }
#define XB_SPIN(cond, bar) do { unsigned _sp = 0; while (cond) { __builtin_amdgcn_s_sleep(1); \
    if ((++_sp & 255u) == 0u) { if (xb_ld(&(bar)[XB_TMO])) break; if (_sp > XB_SPIN_CAP) { atomicAdd(&(bar)[XB_TMO], 1u); break; } } } } while (0)
struct XcdBarrier { unsigned* bar; unsigned x; unsigned nloc, nx; };
DI XcdBarrier xcd_barrier_post(unsigned* bar) {
  XcdBarrier b; b.bar = bar; b.x = xb_xcc_id(); b.nloc = 0u; b.nx = 0u;
  if (threadIdx.x == 0) (void)xb_add(&bar[XB_XCNT(b.x)], 1u);
  return b;
}
DI void xcd_barrier_complete(unsigned* bar, unsigned x, unsigned& nloc, unsigned& nx) {
  const unsigned G = gridDim.x;
  unsigned sum, cnt, mine, sp = 0u;
  for (;;) {
    sum = 0u; cnt = 0u; mine = 0u;
#pragma unroll
    for (unsigned j = 0; j < 16; ++j) { const unsigned c = xb_ld(&bar[XB_XCNT(j)]); sum += c; cnt += (c > 0u) ? 1u : 0u; mine = (j == x) ? c : mine; }
    if (sum == G) break;
    __builtin_amdgcn_s_sleep(1);
    if ((++sp & 255u) == 0u) { if (xb_ld(&bar[XB_TMO])) break; if (sp > XB_SPIN_CAP) { atomicAdd(&bar[XB_TMO], 1u); break; } }
  }
  nloc = mine > 0u ? mine : 1u; nx = cnt > 0u ? cnt : 1u;
}
DI void xcd_barrier(XcdBarrier& b) {
  asm volatile("s_waitcnt vmcnt(0)" ::: "memory");
  if (b.nloc == 0u) {
    unsigned nl, nxx;
    xcd_barrier_complete(b.bar, b.x, nl, nxx);
    b.nloc = __builtin_amdgcn_readfirstlane(nl); b.nx = __builtin_amdgcn_readfirstlane(nxx);
  }
  __syncthreads();
  if (threadIdx.x == 0) {
    unsigned* bar = b.bar;
    __builtin_amdgcn_s_waitcnt(0);
    const unsigned nloc = b.nloc, nx = b.nx;
    const unsigned old = xb_add(&bar[XB_XSUB(b.x)], 1u);
    const unsigned gen = old / nloc;
    if (old + 1u == (gen + 1u) * nloc) {
      __builtin_amdgcn_fence(__ATOMIC_RELEASE, "agent");
      asm volatile("s_waitcnt vmcnt(0)" ::: "memory");
      const unsigned og = xb_add(&bar[XB_TOP], 1u);
      const unsigned tg = og / nx;
      if (og + 1u == (tg + 1u) * nx) xb_add(&bar[XB_TOPGEN], 1u);
      else XB_SPIN(xb_ld(&bar[XB_TOPGEN]) == tg, bar);
      __builtin_amdgcn_fence(__ATOMIC_ACQUIRE, "agent");
      xb_add(&bar[XB_XGEN(b.x)], 1u);
      asm volatile("s_waitcnt vmcnt(0)" ::: "memory");
    } else {
      XB_SPIN(xb_ld(&bar[XB_XGEN(b.x)]) == gen, bar);
      __builtin_amdgcn_fence(__ATOMIC_ACQUIRE, "agent");
      asm volatile("s_waitcnt vmcnt(0)" ::: "memory");
    }
  }
  __syncthreads();
}

__global__ void __launch_bounds__(256, 2) mega(Params p) {
  __shared__ __attribute__((aligned(16))) char lds[65536];
  cg::grid_group grid = cg::this_grid();
  XcdBarrier xb = xcd_barrier_post(p.bar);
#define GRID_SYNC() do { if (p.use_cg) grid.sync(); else xcd_barrier(xb); } while (0)
  phase0(p, lds);
  GRID_SYNC();
  for (int l = 0; l < 4; ++l) {
    phase_inproj(p, l, lds);
#if PROBE_P1
    phase_inproj(p, l, lds);
#endif
    GRID_SYNC();
    phase_attn(p, l, lds);
#if PROBE_B
    if (l == 1) phase_attn(p, l, lds);
#endif
#if PROBE_AC
    if (l != 1) phase_attn(p, l, lds);
#endif
    GRID_SYNC();
    phase_outproj(p, l, lds);
#if PROBE_P3
    if (l == 0) phase_outproj(p, l, lds, true);
#endif
    if (l < 3) GRID_SYNC();
  }
}

extern "C" void kernel_launch(void* const* d_in, const int* in_sizes, int n_in, void* d_out, int out_size, void* d_ws, size_t ws_size, hipStream_t stream) {
  static int grid_blocks = 0;
  if (!grid_blocks) {
    int dev = 0, cus = 0, per_cu = 0;
    (void)hipGetDevice(&dev);
    (void)hipDeviceGetAttribute(&cus, hipDeviceAttributeMultiprocessorCount, dev);
    (void)hipOccupancyMaxActiveBlocksPerMultiprocessor(&per_cu, mega, 256, 0);
    if (per_cu > 2) per_cu = 2;
    grid_blocks = cus * per_cu;
  }
  Params p{};
  p.x = (const float*)d_in[0];
  const int base[4] = {1, 7, 12, 17};
  for (int l = 0; l < 4; ++l) {
    const int b = base[l], hs = (l % 3 == 0) ? 1 : 0;
    p.norm[l] = (const float*)d_in[b]; p.w_in[l] = (const float*)d_in[b + 1]; p.qg[l] = (const float*)d_in[b + 2]; p.kg[l] = (const float*)d_in[b + 3];
    p.sink[l] = hs ? (const float*)d_in[b + 4] : (const float*)d_in[b + 3];
    p.w_out[l] = (const float*)d_in[b + 4 + hs];
  }
  p.out = (float*)d_out;
  char* w = (char*)d_ws; size_t off = 0;
  auto take = [&](size_t bytes) { char* r = w + off; off += (bytes + 255) & ~(size_t)255; return r; };
  p.bar = (unsigned*)take((size_t)XCD_BAR_WORDS * 4); p.use_cg = 0; p.pad0 = 0;
  for (int l = 0; l < 4; ++l) {
    const int kind = l % 3, nin = kind == 2 ? 2816 : 2560, ow = kind == 2 ? 512 : 1024;
    p.wt_in[l] = (bf16_t*)take((size_t)nin * 1024 * 2);
    p.wt_out[l] = (bf16_t*)take((size_t)1024 * ow * 2);
  }
  p.xb = (bf16_t*)take((size_t)S * 1024 * 2);
  p.rs = (float*)take((size_t)4 * S * 4);
  p.Q = (bf16_t*)take((size_t)S * 1536 * 2);
  p.K = (bf16_t*)take((size_t)S * 384 * 2);
  p.Vt = (bf16_t*)take((size_t)6 * 64 * S * 2);
  p.SG = (bf16_t*)take((size_t)S * 1024 * 2);
  p.OG = (bf16_t*)take((size_t)S * 1024 * 2);
  p.rope = (f32x2*)take((size_t)320 * 16 * 8);
  p.wt8 = (unsigned char*)take((size_t)2560 * 1024);
  p.xb8 = (unsigned char*)take((size_t)S * 1024);
  (void)hipMemsetAsync(p.bar, 0, (size_t)XCD_BAR_WORDS * 4, stream);
  void* args[] = {&p};
  hipError_t e = hipLaunchCooperativeKernel((void*)mega, dim3(grid_blocks), dim3(256), args, 0, stream);
  if (e != hipSuccess) fprintf(stderr, "coop launch failed: %s (grid %d)\n", hipGetErrorString(e), grid_blocks);
}
```
